# Optimizing an MI355X kernel written in HIP

```python
import jax, jax.numpy as jnp
from jax import lax
import numpy as np

D_MODEL = 1024
BATCH = 1
SEQ = 16384
DEPTH = 4

N_MIXERS = 3
SWA_HEADS = 16
SWA_KV_HEADS = 4
SWA_HEAD_DIM = 64
SWA_WINDOW = 128
SWA_QKV_DIM = (SWA_HEADS + 2 * SWA_KV_HEADS) * SWA_HEAD_DIM
HGRN_HEADS = 8
HGRN_EXPAND = 128
HGRN_HEAD_DIM = D_MODEL // HGRN_HEADS
HGRN_CHUNK = 64
HGRN_IN_DIM = 2 * HGRN_HEADS * HGRN_EXPAND + 2 * HGRN_HEADS * HGRN_HEAD_DIM
FOX_HEADS = 16
FOX_HEAD_DIM = 64
FOX_BLOCK = 128
FOX_IN_DIM = 3 * FOX_HEADS * FOX_HEAD_DIM + FOX_HEADS
FOX_FORGET_BIAS_INIT = 2.0
D_FF = 4 * D_MODEL
EPS = 1e-6

N_A = (DEPTH + 2) // 3
N_B = (DEPTH + 1) // 3
N_C = DEPTH // 3

kernel_name = "hybrid_swa_hgrn2_fox_trunk"


def rms_norm(x, g):
    xf = x.astype(jnp.float32)
    y = xf * lax.rsqrt(jnp.mean(xf * xf, axis=-1, keepdims=True) + EPS)
    return (y * g.astype(jnp.float32)).astype(x.dtype)


def swa_sink_attention(h, w_qkv, b_qkv, sinks, w_o):
    B, T, _ = h.shape
    W, KV, dh = SWA_WINDOW, SWA_KV_HEADS, SWA_HEAD_DIM
    G = SWA_HEADS // KV
    nb = T // W
    qkv = h @ w_qkv + b_qkv
    q, k, v = jnp.split(qkv, [SWA_HEADS * dh, (SWA_HEADS + KV) * dh], axis=-1)
    q = q.reshape(B, nb, W, KV, G, dh) * (dh ** -0.5)
    k = k.reshape(B, nb, W, KV, dh)
    v = v.reshape(B, nb, W, KV, dh)
    k_band = jnp.concatenate([jnp.pad(k[:, :-1], ((0, 0), (1, 0), (0, 0), (0, 0), (0, 0))), k], axis=2)
    v_band = jnp.concatenate([jnp.pad(v[:, :-1], ((0, 0), (1, 0), (0, 0), (0, 0), (0, 0))), v], axis=2)
    s = jnp.einsum('bnqhgd,bnkhd->bnhgqk', q, k_band).astype(jnp.float32)
    qi = jnp.arange(W)[:, None]
    kk = jnp.arange(2 * W)[None, :]
    rel = qi + W - kk
    in_window = (rel >= 0) & (rel < W)
    blk = jnp.arange(nb)[:, None, None]
    mask = in_window[None] & ((blk > 0) | (kk[None] >= W))
    s = jnp.where(mask[None, :, None, None], s, -jnp.inf)
    sink = sinks.astype(jnp.float32).reshape(KV, G)[None, None, :, :, None, None]
    sink = jnp.broadcast_to(sink, s.shape[:-1] + (1,))
    p = jax.nn.softmax(jnp.concatenate([s, sink], axis=-1), axis=-1)[..., :-1]
    o = jnp.einsum('bnhgqk,bnkhd->bnqhgd', p.astype(v.dtype), v_band)
    return o.reshape(B, T, SWA_HEADS * dh) @ w_o


def hgrn2_mixer(h, w_in, lb, g_norm, w_o):
    B, T, _ = h.shape
    H, K, V, C = HGRN_HEADS, HGRN_EXPAND, HGRN_HEAD_DIM, HGRN_CHUNK
    nc = T // C
    proj = h @ w_in
    q, f_logit, i_in, g = jnp.split(proj, [H * K, 2 * H * K, 2 * H * K + H * V], axis=-1)
    f = lb + (1.0 - lb) * jax.nn.sigmoid(f_logit.astype(jnp.float32))
    log_f = jnp.log(f)
    k = 1.0 - f

    def to_chunks(a, d):
        return a.astype(jnp.float32).reshape(B, nc, C, H, d).transpose(1, 0, 3, 2, 4)

    xs = (to_chunks(jax.nn.silu(q), K), to_chunks(k, K), to_chunks(i_in, V), to_chunks(log_f, K))
    causal = jnp.tril(jnp.ones((C, C), dtype=bool))[:, :, None]

    def step(S, inp):
        qc, kc, vc, gc = inp
        bcum = jnp.cumsum(gc, axis=2)
        diff = jnp.where(causal, bcum[:, :, :, None, :] - bcum[:, :, None, :, :], -jnp.inf)
        A = jnp.einsum('bhtk,bhsk,bhtsk->bhts', qc, kc, jnp.exp(diff))
        o = jnp.einsum('bhts,bhsv->bhtv', A, vc) + jnp.einsum('bhtk,bhkv->bhtv', qc * jnp.exp(bcum), S)
        b_last = bcum[:, :, -1]
        S_new = jnp.exp(b_last)[..., None] * S + jnp.einsum(
            'bhsk,bhsv->bhkv', kc * jnp.exp(b_last[:, :, None, :] - bcum), vc)
        return S_new, o

    S0 = jnp.zeros((B, H, K, V), jnp.float32)
    _, o = lax.scan(step, S0, xs)
    o = o.transpose(1, 0, 3, 2, 4).reshape(B, T, H, V)
    o = o * lax.rsqrt(jnp.mean(o * o, axis=-1, keepdims=True) + EPS)
    o = o.reshape(B, T, H * V) * g_norm.astype(jnp.float32) * jax.nn.silu(g.astype(jnp.float32))
    return o.astype(h.dtype) @ w_o


def fox_attention(h, w_in, b_in, w_o):
    B, T, _ = h.shape
    H, dh, Q = FOX_HEADS, FOX_HEAD_DIM, FOX_BLOCK
    nb = T // Q
    proj = h @ w_in + b_in
    q, k, v, f_logit = jnp.split(proj, [H * dh, 2 * H * dh, 3 * H * dh], axis=-1)
    log_f = jax.nn.log_sigmoid(f_logit.astype(jnp.float32))
    c = jnp.cumsum(log_f, axis=1).transpose(0, 2, 1)
    q = q.reshape(B, T, H, dh) * (dh ** -0.5)
    k = k.reshape(B, T, H, dh)
    v = v.reshape(B, T, H, dh)
    q_blocks = q.reshape(B, nb, Q, H, dh).transpose(1, 0, 2, 3, 4)
    c_blocks = c.reshape(B, H, nb, Q).transpose(2, 0, 1, 3)
    pos_blocks = jnp.arange(T).reshape(nb, Q)
    kpos = jnp.arange(T)

    def block(args):
        qb, cb, pb = args
        s = jnp.einsum('bqhd,bkhd->bhqk', qb, k).astype(jnp.float32)
        s = s + (cb[..., :, None] - c[..., None, :])
        s = jnp.where((pb[:, None] >= kpos[None, :])[None, None], s, -jnp.inf)
        p = jax.nn.softmax(s, axis=-1)
        return jnp.einsum('bhqk,bkhd->bqhd', p.astype(v.dtype), v)

    o = lax.map(block, (q_blocks, c_blocks, pos_blocks))
    o = o.transpose(1, 0, 2, 3, 4).reshape(B, T, H * dh)
    return o @ w_o


def setup_inputs(seed: int = 0) -> dict:
    key = jax.random.key(seed)
    ks = jax.random.split(key, 18)
    f32 = jnp.float32

    def nrm(k, shape, fan_in):
        return jax.random.normal(k, shape, f32) * (fan_in ** -0.5)

    def gain(k, shape):
        return 1.0 + 0.02 * jax.random.normal(k, shape, f32)

    fox_b_in = 0.02 * jax.random.normal(ks[16], (N_C, FOX_IN_DIM), f32)
    fox_b_in = fox_b_in.at[:, 3 * FOX_HEADS * FOX_HEAD_DIM:].add(FOX_FORGET_BIAS_INIT)
    return {
        "x": jax.random.normal(ks[0], (BATCH, SEQ, D_MODEL), f32),
        "norm_mix": gain(ks[1], (DEPTH, D_MODEL)),
        "norm_mlp": gain(ks[2], (DEPTH, D_MODEL)),
        "norm_final": gain(ks[3], (D_MODEL,)),
        "w_up": nrm(ks[4], (DEPTH, D_MODEL, D_FF), D_MODEL),
        "w_down": nrm(ks[5], (DEPTH, D_FF, D_MODEL), D_FF),
        "swa_w_qkv": nrm(ks[6], (N_A, D_MODEL, SWA_QKV_DIM), D_MODEL),
        "swa_b_qkv": 0.02 * jax.random.normal(ks[7], (N_A, SWA_QKV_DIM), f32),
        "swa_sinks": 0.5 * jax.random.normal(ks[8], (N_A, SWA_HEADS), f32),
        "swa_w_o": nrm(ks[9], (N_A, SWA_HEADS * SWA_HEAD_DIM, D_MODEL), SWA_HEADS * SWA_HEAD_DIM),
        "hgrn_w_in": nrm(ks[10], (N_B, D_MODEL, HGRN_IN_DIM), D_MODEL),
        "hgrn_lb_logits": 0.1 * jax.random.normal(ks[11], (DEPTH, HGRN_HEADS * HGRN_EXPAND), f32),
        "hgrn_g_norm": gain(ks[12], (N_B, HGRN_HEADS * HGRN_HEAD_DIM)),
        "hgrn_w_o": nrm(ks[13], (N_B, HGRN_HEADS * HGRN_HEAD_DIM, D_MODEL), HGRN_HEADS * HGRN_HEAD_DIM),
        "fox_w_in": nrm(ks[14], (N_C, D_MODEL, FOX_IN_DIM), D_MODEL),
        "fox_b_in": fox_b_in,
        "fox_w_o": nrm(ks[15], (N_C, FOX_HEADS * FOX_HEAD_DIM, D_MODEL), FOX_HEADS * FOX_HEAD_DIM),
    }


def reference(x, norm_mix, norm_mlp, norm_final, w_up, w_down,
              swa_w_qkv, swa_b_qkv, swa_sinks, swa_w_o,
              hgrn_w_in, hgrn_lb_logits, hgrn_g_norm, hgrn_w_o,
              fox_w_in, fox_b_in, fox_w_o):
    lb_soft = jax.nn.softmax(hgrn_lb_logits.astype(jnp.float32), axis=0)
    lower_bounds = jnp.cumsum(lb_soft, axis=0) - lb_soft[0]
    for i in range(DEPTH):
        h = rms_norm(x, norm_mix[i])
        m, j = i % N_MIXERS, i // N_MIXERS
        if m == 0:
            y = swa_sink_attention(h, swa_w_qkv[j], swa_b_qkv[j], swa_sinks[j], swa_w_o[j])
        elif m == 1:
            y = hgrn2_mixer(h, hgrn_w_in[j], lower_bounds[i], hgrn_g_norm[j], hgrn_w_o[j])
        else:
            y = fox_attention(h, fox_w_in[j], fox_b_in[j], fox_w_o[j])
        x = x + y
        h = rms_norm(x, norm_mlp[i])
        x = x + jnp.square(jax.nn.relu(h @ w_up[i])) @ w_down[i]
    return rms_norm(x, norm_final)
```

```cpp
#include <hip/hip_runtime.h>
#include <hip/hip_cooperative_groups.h>
#include <cstdio>
#include <cstdint>
namespace cg = cooperative_groups;
namespace pg8 {
#define PG8_LAS __attribute__((address_space(3)))
typedef unsigned short bf16_t;
typedef short bf16x8 __attribute__((ext_vector_type(8)));
typedef float f32x4 __attribute__((ext_vector_type(4)));
typedef unsigned u32x4 __attribute__((ext_vector_type(4)));
constexpr int BM = 256, BK = 64, HALF = 128, HTB = HALF * BK * 2  , STAGE_BYTES = 8 * HTB, NXCD = 8, WGM = 8;

__host__ __device__ __forceinline__ int lds_byte(int r, int c) { const int st = (r >> 4) * 2 + (c >> 5), rr = r & 15, cc = c & 31, ob = rr * 64 + cc * 2; return st * 1024 + (ob ^ (((ob >> 9) & 1) << 5)); }
__host__ __device__ __forceinline__ void stage_rc(int b, int& R, int& C) { const int st = b / 1024, sb = b % 1024, swz = sb ^ (((sb >> 9) & 1) << 5); R = (st >> 1) * 16 + swz / 64; C = (st & 1) * 32 + (swz % 64) / 2; }
__host__ __device__ __forceinline__ int perm32(int rho) { const int n = rho >> 4, i = rho & 15; return 8 * (i >> 2) + 4 * n + (i & 3); }

struct Unit { int pm, pn; };
struct Gemm { const bf16_t* A; const bf16_t* Bt; int M, N, K, lda; };

struct StaticOrder {
    int nM, nN, nwg, G, c;
    __host__ __device__ void init(int M, int N, int G_, int c_) { nM = M / BM; nN = N / BM; nwg = nM * nN; G = G_; c = c_; }
    __host__ __device__ bool next(int i, Unit& u) const {
        const long L = (long)i * G + c; if (L >= nwg) return false;
        int wgid = (int)L; { const int q = nwg / NXCD, r = nwg % NXCD, xcd = wgid % NXCD, off = wgid / NXCD; wgid = (xcd < r ? xcd * (q + 1) : r * (q + 1) + (xcd - r) * q) + off; }
        const int nig = WGM * nN, gid = wgid / nig, fm = gid * WGM, gsz = (nM - fm) < WGM ? (nM - fm) : WGM;
        u.pm = fm + ((wgid % nig) % gsz); u.pn = (wgid % nig) / gsz; return true;
    }
    __device__ __forceinline__ void a_ready(const Unit&) const {}
    __device__ __forceinline__ void done(const Unit&) const {}
};

typedef float f32x2_t __attribute__((ext_vector_type(2))); typedef __bf16 bf16x2_t __attribute__((ext_vector_type(2)));
typedef unsigned u32x2 __attribute__((ext_vector_type(2)));
__device__ __forceinline__ unsigned pk2(float lo, float hi) { f32x2_t v = {lo, hi}; bf16x2_t b = __builtin_convertvector(v, bf16x2_t); return __builtin_bit_cast(unsigned, b); }
__device__ __forceinline__ float row_rstd(const float* ssqp, int row) {
    const f32x4* q = (const f32x4*)(ssqp + (size_t)row * 16); const f32x4 a = q[0], b = q[1], c = q[2], d = q[3];
    const float s = (((a[0] + a[1]) + (a[2] + a[3])) + ((b[0] + b[1]) + (b[2] + b[3]))) + (((c[0] + c[1]) + (c[2] + c[3])) + ((d[0] + d[1]) + (d[2] + d[3])));
    return rsqrtf(s * (1.f / 1024.f) + 1e-6f);
}
__device__ __forceinline__ float act1(float v, int a) {
    if (a == 1) { const float r = v > 0.f ? v : 0.f; return r * r; }
    if (a == 2) { return v * __builtin_amdgcn_rcpf(1.f + __expf(-v)); }
    return v;
}
struct EpiAct {
    static constexpr bool PERM = true, AFTER_DRAIN = false;
    bf16_t* O; const float* bias; const float* ssq; unsigned actmask; int nscale; float scale0;
    const PG8_LAS float* rsl; int pmc;
    template <int ACT> __device__ __forceinline__ void body(const f32x4 (&acc)[2][2][4][2], const Unit& u, int wr, int wc, int fr, int fq) const {
        const int row0 = u.pm * BM + wr * 64 + fr, col0 = u.pn * BM + wc * 32 + 8 * fq;
        const float sc = (u.pn < nscale) ? scale0 : 1.f;
        f32x4 bv[2][2];
#pragma unroll
        for (int bj = 0; bj < 2; ++bj)
#pragma unroll
            for (int n = 0; n < 2; ++n) bv[bj][n] = bias ? *(const f32x4*)(bias + col0 + bj * HALF + 4 * n) : (f32x4){0.f, 0.f, 0.f, 0.f};
#pragma unroll
        for (int ai = 0; ai < 2; ++ai)
#pragma unroll
            for (int m = 0; m < 4; ++m) { const int row = row0 + ai * HALF + m * 16; const float rs = (u.pm == pmc) ? rsl[row & 255] : row_rstd(ssq, row);
                bf16_t* rowp = O + (size_t)row * 4096 + col0;
#pragma unroll
                for (int bj = 0; bj < 2; ++bj) { f32x4 v0 = acc[ai][bj][m][0] * rs + bv[bj][0], v1 = acc[ai][bj][m][1] * rs + bv[bj][1];
                    if (ACT != 0) {
#pragma unroll
                        for (int e = 0; e < 4; ++e) { v0[e] = act1(v0[e], ACT); v1[e] = act1(v1[e], ACT); } }
                    v0 = v0 * sc; v1 = v1 * sc; u32x4 w; w.x = pk2(v0[0], v0[1]); w.y = pk2(v0[2], v0[3]); w.z = pk2(v1[0], v1[1]); w.w = pk2(v1[2], v1[3]);
                    *(u32x4*)(rowp + bj * HALF) = w; } }
    }
    __device__ __forceinline__ void operator()(const f32x4 (&acc)[2][2][4][2], const Unit& u, int wr, int wc, int fr, int fq) const {
        const int act = (int)((actmask >> (2 * u.pn)) & 3u);
        if (act == 1) body<1>(acc, u, wr, wc, fr, fq); else if (act == 2) body<2>(acc, u, wr, wc, fr, fq); else body<0>(acc, u, wr, wc, fr, fq);
    }
};
struct EpiResid {
    static constexpr bool PERM = true, AFTER_DRAIN = false;
    bf16_t* xb; float* ssq;
    __device__ __forceinline__ void operator()(const f32x4 (&acc)[2][2][4][2], const Unit& u, int wr, int wc, int fr, int fq) const {
        const int col0 = u.pn * BM + wc * 32 + 8 * fq;
#pragma unroll
        for (int ai = 0; ai < 2; ++ai) {
            u32x4 bv[4][2];
#pragma unroll
            for (int m = 0; m < 4; ++m) { const size_t off = (size_t)(u.pm * BM + ai * HALF + wr * 64 + m * 16 + fr) * 1024 + col0;
#pragma unroll
                for (int bj = 0; bj < 2; ++bj) bv[m][bj] = *(const u32x4*)(xb + off + bj * HALF); }
#pragma unroll
            for (int m = 0; m < 4; ++m) { const int row = u.pm * BM + ai * HALF + wr * 64 + m * 16 + fr; const size_t off = (size_t)row * 1024 + col0; float s = 0.f;
#pragma unroll
                for (int bj = 0; bj < 2; ++bj) { const u32x4 b = bv[m][bj]; const f32x4 a0 = acc[ai][bj][m][0], a1 = acc[ai][bj][m][1];
                    const float x0 = __uint_as_float(b.x << 16) + a0[0], x1 = __uint_as_float(b.x & 0xffff0000u) + a0[1], x2 = __uint_as_float(b.y << 16) + a0[2], x3 = __uint_as_float(b.y & 0xffff0000u) + a0[3];
                    const float x4 = __uint_as_float(b.z << 16) + a1[0], x5 = __uint_as_float(b.z & 0xffff0000u) + a1[1], x6 = __uint_as_float(b.w << 16) + a1[2], x7 = __uint_as_float(b.w & 0xffff0000u) + a1[3];
                    u32x4 w; w.x = pk2(x0, x1); w.y = pk2(x2, x3); w.z = pk2(x4, x5); w.w = pk2(x6, x7); *(u32x4*)(xb + off + bj * HALF) = w;
                    s += ((x0 * x0 + x1 * x1) + (x2 * x2 + x3 * x3)) + ((x4 * x4 + x5 * x5) + (x6 * x6 + x7 * x7)); }
                s += __shfl_xor(s, 16); s += __shfl_xor(s, 32);
                if (fq == 0) ssq[(size_t)row * 16 + u.pn * 4 + wc] = s; } }
    }
};

template <class Epi, class Sched, int KC, int LDA, bool ALIGN_EPI = false, bool SP2 = false>
__device__ __forceinline__ void gemm_phase(PG8_LAS unsigned char* lds, const Gemm g, const Sched& S, const Epi& E, const int tid) {
    const int wid = __builtin_amdgcn_readfirstlane(tid >> 6), lane = tid & 63, wr = wid >> 2, wc = wid & 3, fr = lane & 15, fq = lane >> 4;
    constexpr int K = KC, nt = KC / BK;
    unsigned voffA[2], voffB[2];
#pragma unroll
    for (int i = 0; i < 2; ++i) { int R, C; stage_rc(tid * 16 + i * 8192, R, C); const int Rb = Epi::PERM ? ((R & ~31) + perm32(R & 31)) : R;
        voffA[i] = (unsigned)(R * LDA + C) * 2u; voffB[i] = (unsigned)(Rb * K + C) * 2u; }
    const size_t kstep = (size_t)(BK * 2);
    const size_t hstepA = (size_t)HALF * LDA * 2, hstepB = (size_t)HALF * K * 2;
    const size_t tstepA = 2 * hstepA, tstepB = 2 * hstepB;
    const unsigned ldsw = (unsigned)wid * 1024u;
    const int aoff = lds_byte(wr * 64 + fr, fq * 8), boff = lds_byte(wc * 32 + fr, fq * 8);
#define PG8_SA(b, h) (((b) * 2 + (h)) * HTB)
#define PG8_SB(b, h) ((4 + (b) * 2 + (h)) * HTB)
#define PG8_STAGE(bufoff, gbase, voff) do { _Pragma("unroll") for (int _i = 0; _i < 2; ++_i) \
        __builtin_amdgcn_global_load_lds((const unsigned*)((const char*)(gbase) + (voff)[_i]), (PG8_LAS unsigned*)(lds + (bufoff) + ldsw + _i * 8192), 16, 0, 0); } while (0)
#define PG8_LDA(dst, b, h) do { _Pragma("unroll") for (int m = 0; m < 4; ++m) _Pragma("unroll") for (int k = 0; k < 2; ++k) dst[m][k] = *(const PG8_LAS bf16x8*)(lds + PG8_SA(b, h) + aoff + m * 2048 + k * 1024); } while (0)
#define PG8_LDB(dst, b, h) do { _Pragma("unroll") for (int n = 0; n < 2; ++n) _Pragma("unroll") for (int k = 0; k < 2; ++k) dst[n][k] = *(const PG8_LAS bf16x8*)(lds + PG8_SB(b, h) + boff + n * 2048 + k * 1024); } while (0)
#define PG8_MMA(ai, bj, At, Bt) do { __builtin_amdgcn_s_setprio(1); _Pragma("unroll") for (int m = 0; m < 4; ++m) _Pragma("unroll") for (int n = 0; n < 2; ++n) _Pragma("unroll") for (int k = 0; k < 2; ++k) \
        acc[ai][bj][m][n] = __builtin_amdgcn_mfma_f32_16x16x32_bf16(Bt[n][k], At[m][k], acc[ai][bj][m][n], 0, 0, 0); __builtin_amdgcn_s_setprio(0); } while (0)
#define PG8_WAIT_V(n) asm volatile("s_waitcnt vmcnt(" #n ")" ::: "memory")
#define PG8_WAIT_L(n) asm volatile("s_waitcnt lgkmcnt(" #n ")" ::: "memory")
#define PG8_BAR __builtin_amdgcn_s_barrier()
#define PG8_SCHED __builtin_amdgcn_sched_barrier(0)
    Unit cur, nxt; int ui = 0;
    if (!S.next(0, cur)) return;
    f32x4 acc[2][2][4][2];
#pragma unroll
    for (int a = 0; a < 2; ++a)
#pragma unroll
        for (int b = 0; b < 2; ++b)
#pragma unroll
            for (int m = 0; m < 4; ++m)
#pragma unroll
                for (int n = 0; n < 2; ++n) acc[a][b][m][n] = (f32x4){0.f, 0.f, 0.f, 0.f};
    bf16x8 At[4][2], B0[2][2], B1[2][2];
    const char* cA = (const char*)g.A + (size_t)cur.pm * tstepA; const char* cB = (const char*)g.Bt + (size_t)cur.pn * tstepB;
    S.a_ready(cur);
    if constexpr (SP2) {
        PG8_STAGE(PG8_SB(0, 0), cB, voffB); PG8_STAGE(PG8_SB(0, 1), cB + hstepB, voffB); PG8_STAGE(PG8_SA(0, 0), cA, voffA); PG8_STAGE(PG8_SA(0, 1), cA + hstepA, voffA);
        if (wr == 1) PG8_BAR;
        PG8_WAIT_V(2); PG8_BAR;
        PG8_STAGE(PG8_SB(1, 0), cB + kstep, voffB); PG8_STAGE(PG8_SA(1, 0), cA + kstep, voffA); PG8_STAGE(PG8_SB(1, 1), cB + hstepB + kstep, voffB);
        PG8_WAIT_V(6); PG8_BAR;
    } else {
        PG8_STAGE(PG8_SB(0, 0), cB, voffB); PG8_STAGE(PG8_SA(0, 0), cA, voffA); PG8_STAGE(PG8_SB(0, 1), cB + hstepB, voffB); PG8_STAGE(PG8_SA(0, 1), cA + hstepA, voffA);
        if (wr == 1) PG8_BAR;
        PG8_WAIT_V(4); PG8_BAR;
        PG8_STAGE(PG8_SB(1, 0), cB + kstep, voffB); PG8_STAGE(PG8_SA(1, 0), cA + kstep, voffA); PG8_STAGE(PG8_SB(1, 1), cB + hstepB + kstep, voffB);
        PG8_WAIT_V(6); PG8_BAR;
    }
    for (;;) {
        const bool has_next = S.next(ui + 1, nxt);
        const char* nA = has_next ? (const char*)g.A + (size_t)nxt.pm * tstepA : cA; const char* nB = has_next ? (const char*)g.Bt + (size_t)nxt.pn * tstepB : cB;
        for (int t = 0; t < nt; t += 2) {
            const bool last = (t == nt - 2);
            const char* a1 = cA + (size_t)(t + 1) * kstep;
            const char* a2 = last ? nA : cA + (size_t)(t + 2) * kstep; const char* b2 = last ? nB : cB + (size_t)(t + 2) * kstep;
            const char* a3 = a2 + kstep; const char* b3 = b2 + kstep;
            if (last && has_next) S.a_ready(nxt);
            if constexpr (SP2) {
            PG8_LDB(B0, 0, 0); PG8_LDB(B1, 0, 1); PG8_SCHED; PG8_LDA(At, 0, 0); PG8_STAGE(PG8_SA(1, 1), a1 + hstepA, voffA);
            PG8_WAIT_V(8); PG8_WAIT_L(0); PG8_BAR; PG8_MMA(0, 0, At, B0); PG8_MMA(0, 1, At, B1); PG8_BAR; PG8_SCHED;
            PG8_LDA(At, 0, 1); PG8_STAGE(PG8_SB(0, 0), b2, voffB); PG8_STAGE(PG8_SB(0, 1), b2 + hstepB, voffB); PG8_STAGE(PG8_SA(0, 0), a2, voffA);
            PG8_WAIT_V(8); PG8_WAIT_L(0); PG8_BAR; PG8_MMA(1, 0, At, B0); PG8_MMA(1, 1, At, B1); PG8_BAR; PG8_SCHED;
            PG8_LDB(B0, 1, 0); PG8_LDB(B1, 1, 1); PG8_SCHED; PG8_LDA(At, 1, 0); PG8_STAGE(PG8_SA(0, 1), a2 + hstepA, voffA);
            PG8_WAIT_V(8); PG8_WAIT_L(0); PG8_BAR; PG8_MMA(0, 0, At, B0); PG8_MMA(0, 1, At, B1); PG8_BAR; PG8_SCHED;
            PG8_LDA(At, 1, 1); PG8_STAGE(PG8_SB(1, 0), b3, voffB); PG8_STAGE(PG8_SB(1, 1), b3 + hstepB, voffB); PG8_STAGE(PG8_SA(1, 0), a3, voffA);
            PG8_WAIT_V(8); PG8_WAIT_L(0); PG8_BAR; PG8_MMA(1, 0, At, B0); PG8_MMA(1, 1, At, B1); PG8_BAR; PG8_SCHED;
            } else {
            PG8_LDB(B0, 0, 0); PG8_SCHED; PG8_LDA(At, 0, 0); PG8_STAGE(PG8_SA(1, 1), a1 + hstepA, voffA);
            PG8_WAIT_L(8); PG8_BAR; PG8_WAIT_L(0); PG8_MMA(0, 0, At, B0); PG8_BAR; PG8_SCHED;
            PG8_LDB(B1, 0, 1); PG8_STAGE(PG8_SB(0, 0), b2, voffB);
            PG8_BAR; PG8_WAIT_L(0); PG8_MMA(0, 1, At, B1); PG8_BAR;
            PG8_LDA(At, 0, 1); PG8_STAGE(PG8_SA(0, 0), a2, voffA);
            PG8_BAR; PG8_WAIT_L(0); PG8_MMA(1, 0, At, B0); PG8_BAR; PG8_SCHED;
            PG8_STAGE(PG8_SB(0, 1), b2 + hstepB, voffB);
            PG8_WAIT_V(6); PG8_BAR; PG8_MMA(1, 1, At, B1); PG8_BAR;
            PG8_LDB(B0, 1, 0); PG8_SCHED; PG8_LDA(At, 1, 0); PG8_STAGE(PG8_SA(0, 1), a2 + hstepA, voffA);
            PG8_WAIT_L(8); PG8_BAR; PG8_WAIT_L(0); PG8_MMA(0, 0, At, B0); PG8_BAR; PG8_SCHED;
            PG8_LDB(B1, 1, 1); PG8_STAGE(PG8_SB(1, 0), b3, voffB);
            PG8_BAR; PG8_WAIT_L(0); PG8_MMA(0, 1, At, B1); PG8_BAR;
            PG8_LDA(At, 1, 1); PG8_STAGE(PG8_SA(1, 0), a3, voffA);
            PG8_BAR; PG8_WAIT_L(0); PG8_MMA(1, 0, At, B0); PG8_BAR; PG8_SCHED;
            PG8_STAGE(PG8_SB(1, 1), b3 + hstepB, voffB);
            PG8_WAIT_V(6); PG8_BAR; PG8_MMA(1, 1, At, B1); PG8_BAR;
            }
        }
        if constexpr (ALIGN_EPI) { if (wr == 0) PG8_BAR; }
        if constexpr (!Epi::AFTER_DRAIN) { E(acc, cur, wr, wc, fr, fq); S.done(cur); }
        if (!has_next) break;
#pragma unroll
        for (int a = 0; a < 2; ++a)
#pragma unroll
            for (int b = 0; b < 2; ++b)
#pragma unroll
                for (int m = 0; m < 4; ++m)
#pragma unroll
                    for (int n = 0; n < 2; ++n) acc[a][b][m][n] = (f32x4){0.f, 0.f, 0.f, 0.f};
        cur = nxt; cA = nA; cB = nB; ++ui;
        if constexpr (ALIGN_EPI) { if (wr == 1) PG8_BAR; }
    }
    PG8_WAIT_V(0);
    if constexpr (!ALIGN_EPI) { if (wr == 0) PG8_BAR; }
    PG8_BAR;
    if constexpr (Epi::AFTER_DRAIN) { E.fused(acc, cur, wr, wc, fr, fq, lds, wid, lane); S.done(cur); }
#undef PG8_SA
#undef PG8_SB
#undef PG8_STAGE
#undef PG8_LDA
#undef PG8_LDB
#undef PG8_MMA
#undef PG8_WAIT_V
#undef PG8_WAIT_L
#undef PG8_BAR
#undef PG8_SCHED
}
}
#define LAS __attribute__((address_space(3)))
typedef unsigned short bf16_t;
typedef short bf16x8 __attribute__((ext_vector_type(8)));
typedef short s16x4 __attribute__((ext_vector_type(4)));
typedef float f32x4 __attribute__((ext_vector_type(4)));
typedef float f32x16 __attribute__((ext_vector_type(16)));
typedef unsigned u32x4 __attribute__((ext_vector_type(4)));
typedef unsigned u32x2 __attribute__((ext_vector_type(2)));
using pg8::pk2; using pg8::row_rstd;
#define MFMA16(a, b, c) __builtin_amdgcn_mfma_f32_16x16x32_bf16((a), (b), (c), 0, 0, 0)
#define MFMA32(a, b, c) __builtin_amdgcn_mfma_f32_32x32x16_bf16((a), (b), (c), 0, 0, 0)

constexpr int T = 16384, D = 1024, FF = 4096, NTHR = 512, NWV = 8;
constexpr float EPS = 1e-6f, LOG2E = 1.4426950408889634f;
constexpr size_t MiB = 1u << 20;
constexpr size_t WS_BIG = 0, WS_XB = 128 * MiB, WS_WMIX = 160 * MiB, WS_WMLP = 172 * MiB, WS_DS = 188 * MiB, WS_MISC = 204 * MiB;
constexpr size_t WS_SSQ = WS_MISC  , WS_LF = WS_MISC + 9 * MiB, WS_C2 = WS_MISC + 10 * MiB, WS_PK = WS_MISC + 11 * MiB, WS_DSEG = WS_MISC + 12 * MiB, WS_SEG = WS_MISC + 13 * MiB  , WS_BAR = WS_MISC + 14 * MiB  , WS_END = WS_MISC + 15 * MiB;
constexpr int LDS_CTL = 8 * 17664;
constexpr int LDS_BYTES = 8 * 17664 + 1024;

struct Params { const float* in[17]; float* out; unsigned char* ws; };
typedef const __attribute__((address_space(4))) Params* PP;

__device__ __forceinline__ float bf_lo(unsigned w) { return __uint_as_float(w << 16); }
__device__ __forceinline__ float bf_hi(unsigned w) { return __uint_as_float(w & 0xffff0000u); }
__device__ __forceinline__ float bf_get(const u32x4& v, int i) { const unsigned w = v[i >> 1]; return (i & 1) ? bf_hi(w) : bf_lo(w); }
__device__ __forceinline__ float wave_sum(float v) {
#pragma unroll
    for (int o = 1; o < 64; o <<= 1) v += __shfl_xor(v, o);
    return v;
}
#define LDS_WAIT() asm volatile("s_waitcnt lgkmcnt(0)" ::: "memory")
#define LBAR() do { asm volatile("s_waitcnt lgkmcnt(0)" ::: "memory"); __builtin_amdgcn_s_barrier(); asm volatile("" ::: "memory"); } while (0)

#define RLX_AGENT __ATOMIC_RELAXED, __HIP_MEMORY_SCOPE_AGENT
#define XB_TMO      128
#define XB_XCNT(j)  (256  + 64 * (j))
#define XB_XSUB(j)  (1280 + 64 * (j))
#define XB_XGEN(j)  (2304 + 64 * (j))
#define XB_TOP      3328
#define XB_TOPGEN   3392
#define XCD_BAR_WORDS 3456
#define XB_SPIN_CAP (1u << 18)

__device__ __forceinline__ unsigned xb_ld(unsigned* p)              { return __hip_atomic_load(p, __ATOMIC_RELAXED, __HIP_MEMORY_SCOPE_AGENT); }
__device__ __forceinline__ unsigned xb_add(unsigned* p, unsigned v) { return __hip_atomic_fetch_add(p, v, __ATOMIC_RELAXED, __HIP_MEMORY_SCOPE_AGENT); }
__device__ __forceinline__ unsigned xb_xcc_id() { return (unsigned)__builtin_amdgcn_s_getreg((3 << 11) | 20) & 0xFu; }
#define XB_SPIN(cond, bar) do { unsigned _sp = 0; while (cond) { __builtin_amdgcn_s_sleep(1); \
    if ((++_sp & 255u) == 0u) { if (xb_ld(&(bar)[XB_TMO])) break; if (_sp > XB_SPIN_CAP) { atomicAdd(&(bar)[XB_TMO], 1u); break; } } } } while (0)

struct XcdBarrier {
    unsigned* bar; unsigned x;
    volatile LAS unsigned* st;
};

__device__ __forceinline__ XcdBarrier xcd_barrier_post(unsigned* bar, volatile LAS unsigned* st) {
    XcdBarrier b; b.bar = bar; b.x = xb_xcc_id(); b.st = st;
    if (threadIdx.x == 0) (void)xb_add(&bar[XB_XCNT(b.x)], 1u);
    return b;
}
__device__ __forceinline__ void xcd_barrier_complete(unsigned* bar, unsigned x, unsigned& nloc, unsigned& nx) {
    const unsigned G = gridDim.x * gridDim.y * gridDim.z;
    unsigned sum, cnt, mine, sp = 0u;
    for (;;) {
        sum = 0u; cnt = 0u; mine = 0u;
#pragma unroll
        for (unsigned j = 0; j < 16; ++j) { const unsigned c = xb_ld(&bar[XB_XCNT(j)]); sum += c; cnt += (c > 0u) ? 1u : 0u; mine = (j == x) ? c : mine; }
        if (sum == G) break;
        __builtin_amdgcn_s_sleep(1);
        if ((++sp & 255u) == 0u) { if (xb_ld(&bar[XB_TMO])) break; if (sp > XB_SPIN_CAP) { atomicAdd(&bar[XB_TMO], 1u); break; } }
    }
    nloc = mine > 0u ? mine : 1u; nx = cnt > 0u ? cnt : 1u;
}

__device__ __forceinline__ void xcd_barrier(const XcdBarrier& b) {
    asm volatile("s_waitcnt vmcnt(0)" ::: "memory");
    __syncthreads();
    if (threadIdx.x == 0) {
        unsigned* bar = b.bar;
        __builtin_amdgcn_s_waitcnt(0);
        unsigned nloc = b.st[0], nx = b.st[1];
        if (nloc == 0u) { xcd_barrier_complete(bar, b.x, nloc, nx); b.st[0] = nloc; b.st[1] = nx; }
        const unsigned old = xb_add(&bar[XB_XSUB(b.x)], 1u);
        const unsigned gen = old / nloc;
        if (old + 1u == (gen + 1u) * nloc) {
            __builtin_amdgcn_fence(__ATOMIC_RELEASE, "agent");
            asm volatile("s_waitcnt vmcnt(0)" ::: "memory");
            const unsigned og = xb_add(&bar[XB_TOP], 1u);
            const unsigned tg = og / nx;
            if (og + 1u == (tg + 1u) * nx) xb_add(&bar[XB_TOPGEN], 1u);
            else XB_SPIN(xb_ld(&bar[XB_TOPGEN]) == tg, bar);
            __builtin_amdgcn_fence(__ATOMIC_ACQUIRE, "agent");
            xb_add(&bar[XB_XGEN(b.x)], 1u);
            asm volatile("s_waitcnt vmcnt(0)" ::: "memory");
        } else {
            XB_SPIN(xb_ld(&bar[XB_XGEN(b.x)]) == gen, bar);
            __builtin_amdgcn_fence(__ATOMIC_ACQUIRE, "agent");
            asm volatile("s_waitcnt vmcnt(0)" ::: "memory");
        }
    }
    __syncthreads();
}

constexpr int CONV_SCR_BYTES = 17664;
__device__ __forceinline__ void conv_load(f32x4 (&v)[8], const float* W, int ldw, int kb, int nb, int lane) {
    const int k0 = 64 * kb, n0 = 32 * nb, kr = lane >> 3, nc = (lane & 7) * 4;
#pragma unroll
    for (int i = 0; i < 8; ++i) v[i] = __builtin_nontemporal_load((const f32x4*)(W + (size_t)(k0 + 8 * i + kr) * ldw + n0 + nc));
}
__device__ __forceinline__ void conv_store(const f32x4 (&v)[8], int K, bf16_t* WT, const float* gain, LAS float* scr, int kb, int nb, int lane) {
    const int k0 = 64 * kb, n0 = 32 * nb, kr = lane >> 3, nc = (lane & 7) * 4;
    float g[8];
#pragma unroll
    for (int i = 0; i < 8; ++i) g[i] = gain ? gain[k0 + 8 * i + kr] : 1.f;
#pragma unroll
    for (int i = 0; i < 8; ++i) { const int k = 8 * i + kr; *(LAS f32x4*)(scr + k * 36 + 4 * (k >> 3) + nc) = v[i] * g[i]; }
    LDS_WAIT();
    const int c = lane & 7;
#pragma unroll
    for (int j = 0; j < 4; ++j) { const int n = (lane >> 3) + 8 * j; const LAS float* s = scr + (8 * c) * 36 + 4 * c + n;
        u32x4 o; o.x = pk2(s[0 * 36], s[1 * 36]); o.y = pk2(s[2 * 36], s[3 * 36]); o.z = pk2(s[4 * 36], s[5 * 36]); o.w = pk2(s[6 * 36], s[7 * 36]);
        *(u32x4*)(WT + (size_t)(n0 + n) * K + k0 + 8 * c) = o; }
    LDS_WAIT();
}
__device__ __forceinline__ void convert_w(const float* W, int ldw, int K, int N, bf16_t* WT, const float* gain, LAS float* scr, int gw, int ngw, int lane) {
    const int nblk = N / 32, nitems = (K / 64) * nblk;
    f32x4 v[8], v1[8], v2[8];
#pragma unroll
    for (int i = 0; i < 8; ++i) { v[i] = (f32x4){0.f, 0.f, 0.f, 0.f}; v1[i] = v[i]; v2[i] = v[i]; }
    int it = gw;
    if (it < nitems) conv_load(v, W, ldw, it / nblk, it % nblk, lane);
    if (it + ngw < nitems) conv_load(v1, W, ldw, (it + ngw) / nblk, (it + ngw) % nblk, lane);
    while (it < nitems) { const int n2 = it + 2 * ngw;
        if (n2 < nitems) conv_load(v2, W, ldw, n2 / nblk, n2 % nblk, lane);
        conv_store(v, K, WT, gain, scr, it / nblk, it % nblk, lane);
#pragma unroll
        for (int i = 0; i < 8; ++i) { v[i] = v1[i]; v1[i] = v2[i]; }
        it += ngw; }
}
__device__ __forceinline__ void conv_mix(PP p, int L, LAS float* scr, int gw, int ngw, int lane) {
    bf16_t* wm = (bf16_t*)(p->ws + WS_WMIX); const float* gain = p->in[1] + L * 1024; const int m = L % 3, j = L / 3;
    if (m == 0) { convert_w(p->in[6] + (size_t)j * 1024 * 1536, 1536, 1024, 1536, wm, gain, scr, gw, ngw, lane);
                  convert_w(p->in[9] + (size_t)j * 1024 * 1024, 1024, 1024, 1024, wm + 1536 * 1024, nullptr, scr, gw, ngw, lane); }
    else if (m == 1) { convert_w(p->in[10] + (size_t)j * 1024 * 4096, 4096, 1024, 4096, wm, gain, scr, gw, ngw, lane);
                       convert_w(p->in[13] + (size_t)j * 1024 * 1024, 1024, 1024, 1024, wm + 4096 * 1024, nullptr, scr, gw, ngw, lane); }
    else { const float* w = p->in[14] + (size_t)j * 1024 * 3088;
           convert_w(w, 3088, 1024, 3072, wm, gain, scr, gw, ngw, lane);
           convert_w(p->in[16] + (size_t)j * 1024 * 1024, 1024, 1024, 1024, wm + 3072 * 1024, nullptr, scr, gw, ngw, lane);
           bf16_t* wf = wm + 4096 * 1024;
           for (int idx = gw * 64 + lane; idx < 16 * 1024; idx += ngw * 64) { const int h = idx & 15, k = idx >> 4; wf[h * 1024 + k] = (bf16_t)(pk2(w[(size_t)k * 3088 + 3072 + h] * gain[k], 0.f) & 0xffffu); } }
}
__device__ __forceinline__ void conv_mlp(PP p, int L, LAS float* scr, int gw, int ngw, int lane) {
    bf16_t* wl = (bf16_t*)(p->ws + WS_WMLP);
    convert_w(p->in[4] + (size_t)L * 1024 * 4096, 4096, 1024, 4096, wl, p->in[2] + L * 1024, scr, gw, ngw, lane);
    convert_w(p->in[5] + (size_t)L * 4096 * 1024, 1024, 4096, 1024, wl + 4096 * 1024, nullptr, scr, gw, ngw, lane);
}

template <class Epi, int NC, int KC, int LDA> __device__ __forceinline__ void run_gemm(LAS unsigned char* lds, const bf16_t* A, const bf16_t* Bt, const Epi& E, int tid, int bid, int nblk) {
    pg8::Gemm g{A, Bt, T, NC, KC, LDA}; pg8::StaticOrder S; S.init(T, NC, nblk, bid);
    pg8::gemm_phase<Epi, pg8::StaticOrder, KC, LDA, true, true>(lds, g, S, E, tid);
}
typedef short v4i16_t __attribute__((ext_vector_type(4)));
__device__ __forceinline__ s16x4 vtr(const LAS unsigned char* p) { return __builtin_bit_cast(s16x4, __builtin_amdgcn_ds_read_tr16_b64_v4i16((LAS v4i16_t*)p)); }
struct AttnCfg { bf16_t* buf; int ld, koff, voff, ooff, fox; const float* sinks; const float* c2; const float* pk; const float* seg; };
__device__ __forceinline__ void attn_phase(LAS unsigned char* lds, const AttnCfg c, const int tid, const int bid, const int nblk) {
    constexpr bool FOXC = true;
    const int lane = tid & 63, wid = __builtin_amdgcn_readfirstlane(tid >> 6), r32 = lane & 31, hi = lane >> 5;
    LAS unsigned char* Kl = lds; LAS unsigned char* Vl = lds + 9216; LAS float* c2t = (LAS float*)(lds + 18432); LAS int* flags = (LAS int*)(lds + 18688); LAS float* soff = (LAS float*)(lds + 18816); LAS float* smax = soff + 16; LAS float* bnd = soff + 32;
    const int srow = tid >> 3, sch = tid & 7;
    const float NEG = -INFINITY;
    for (int u = bid; u < 1024; u += nblk) {
        const int h = FOXC ? (u & 15) : 4 * (u & 3) + (wid & 3), qb = FOXC ? (u >> 4) : (u >> 2), kvh = FOXC ? h : (u & 3);
        const int tw = FOXC ? qb * 256 + 32 * wid : qb * 64 + 32 * (wid >> 2), qpos = tw + r32;
        const bf16_t* qp = c.buf + (size_t)qpos * c.ld + h * 64 + 8 * hi;
        bf16x8 qr[4];
#pragma unroll
        for (int d0 = 0; d0 < 4; ++d0) qr[d0] = *(const bf16x8*)(qp + 16 * d0);
        if (FOXC) {
            if (wid == 0) { const float v = (lane < 16) ? c.seg[h * 16 + lane] : 0.f, mv = (lane < 16) ? c.seg[256 + h * 16 + lane] : 0.f; float is = v, im = mv;
#pragma unroll
                for (int o = 1; o < 16; o <<= 1) { const float x = __shfl_up(is, o), y = __shfl_up(im, o); if (lane >= o) { is += x; im = fmaxf(im, y); } }
                float em = __shfl_up(im, 1); if (lane == 0) em = 0.f;
                if (lane < 16) { soff[lane] = is - v; smax[lane] = em; } }
            LBAR(); }
        float qn = 0.f, cq = 0.f;
        if (FOXC) { float ss = 0.f;
#pragma unroll
            for (int d0 = 0; d0 < 4; ++d0)
#pragma unroll
                for (int e = 0; e < 8; ++e) { const float v = __uint_as_float(((unsigned)(unsigned short)qr[d0][e]) << 16); ss += v * v; }
            ss += __shfl_xor(ss, 32); qn = sqrtf(ss) * 1.0001f; cq = c.c2[(size_t)h * T + qpos] + soff[qpos >> 10]; }
        float m = FOXC ? -1e30f : c.sinks[h] * LOG2E, l = FOXC ? 0.f : (hi == 0 ? 1.f : 0.f);
        f32x16 o0, o1;
#pragma unroll
        for (int i = 0; i < 16; ++i) { o0[i] = 0.f; o1[i] = 0.f; }
        const int kt_hi = FOXC ? 4 * qb + 3 : qb, kt_lo = FOXC ? 0 : (qb - 2 > 0 ? qb - 2 : 0);
        const bf16_t* kg = c.buf + c.koff + kvh * 64 + sch * 8; const bf16_t* vg = c.buf + c.voff + kvh * 64 + sch * 8;
        u32x4 kst, vst, kst1 = {0u, 0u, 0u, 0u}, vst1 = {0u, 0u, 0u, 0u}; float cst = 0.f, cst1 = 0.f, pst1 = 0.f;
        { const size_t r = (size_t)(64 * kt_hi + srow) * c.ld; kst = *(const u32x4*)(kg + r); vst = *(const u32x4*)(vg + r); if (FOXC && tid < 64) cst = c.c2[(size_t)h * T + 64 * kt_hi + tid]; }
        if (kt_hi > kt_lo) { const size_t r = (size_t)(64 * (kt_hi - 1) + srow) * c.ld; kst1 = *(const u32x4*)(kg + r); vst1 = *(const u32x4*)(vg + r);
            if (FOXC && tid < 64) { cst1 = c.c2[(size_t)h * T + 64 * (kt_hi - 1) + tid]; if (tid == 63) pst1 = c.pk[(size_t)h * T + 64 * (kt_hi - 1) + 63]; } }
        bool active = true; int par = 0;
        for (int kt = kt_hi;; --kt) {
            *(LAS u32x4*)(Kl + srow * 144 + sch * 16) = kst;
            *(LAS u32x4*)(Vl + srow * 144 + sch * 16) = vst;
            if (FOXC && tid < 64) { c2t[tid] = cst; if (tid == 63) { bnd[0] = cst1; bnd[1] = pst1; } }
            LBAR();
            kst = kst1; vst = vst1; cst = cst1;
            float pkn = 0.f, c2n = 0.f;
            if (FOXC && kt > 0) { const int sp = 64 * kt - 1; pkn = fmaxf(bnd[1], smax[sp >> 10]); c2n = bnd[0] + soff[sp >> 10]; }
            if (kt - 2 >= kt_lo) { const size_t r = (size_t)(64 * (kt - 2) + srow) * c.ld; kst1 = *(const u32x4*)(kg + r); vst1 = *(const u32x4*)(vg + r);
                if (FOXC && tid < 64) { cst1 = c.c2[(size_t)h * T + 64 * (kt - 2) + tid]; if (tid == 63) pst1 = c.pk[(size_t)h * T + 64 * (kt - 2) + 63]; } }
            const bool causal_skip = 64 * kt > tw + 31;
            bool rel = active && !causal_skip; if (!FOXC) rel = rel && (64 * kt + 63 >= tw - 127);
            if (rel) {
                f32x16 p0, p1;
#pragma unroll
                for (int i = 0; i < 16; ++i) { p0[i] = 0.f; p1[i] = 0.f; }
#pragma unroll
                for (int d0 = 0; d0 < 4; ++d0) { const bf16x8 a0 = *(const LAS bf16x8*)(Kl + r32 * 144 + d0 * 32 + hi * 16), a1 = *(const LAS bf16x8*)(Kl + (32 + r32) * 144 + d0 * 32 + hi * 16);
                    __builtin_amdgcn_s_setprio(1); p0 = MFMA32(a0, qr[d0], p0); p1 = MFMA32(a1, qr[d0], p1); __builtin_amdgcn_s_setprio(0); }
                const bool full = (64 * kt + 63 <= tw) && (FOXC || (tw + 31 - 64 * kt < 128));
                const float cqt = FOXC ? cq - soff[kt >> 4] : 0.f;
                float rm = NEG;
                f32x4 cA[4], cB[4];
                if (FOXC) {
#pragma unroll
                    for (int g = 0; g < 4; ++g) { cA[g] = *(const LAS f32x4*)(c2t + 8 * g + 4 * hi); cB[g] = *(const LAS f32x4*)(c2t + 32 + 8 * g + 4 * hi); } }
#pragma unroll
                for (int i = 0; i < 16; ++i) { const int kvl = (i & 3) + 8 * (i >> 2) + 4 * hi; float s0 = p0[i], s1 = p1[i];
                    if (FOXC) { s0 += cqt - cA[i >> 2][i & 3]; s1 += cqt - cB[i >> 2][i & 3]; }
                    if (!full) { const int kv0 = 64 * kt + kvl, kv1 = kv0 + 32; bool v0 = kv0 <= qpos, v1 = kv1 <= qpos;
                        if (!FOXC) { v0 = v0 && (qpos - kv0 < 128); v1 = v1 && (qpos - kv1 < 128); }
                        s0 = v0 ? s0 : NEG; s1 = v1 ? s1 : NEG; }
                    p0[i] = s0; p1[i] = s1; rm = fmaxf(rm, fmaxf(s0, s1)); }
                rm = fmaxf(rm, __shfl_xor(rm, 32));
                float mn = m; if (__any((rm > m + 8.f) ? 1 : 0)) mn = fmaxf(m, rm);
                const float alpha = __builtin_amdgcn_exp2f(m - mn); m = mn;
                float ls = 0.f;
#pragma unroll
                for (int i = 0; i < 16; ++i) { p0[i] = __builtin_amdgcn_exp2f(p0[i] - mn); p1[i] = __builtin_amdgcn_exp2f(p1[i] - mn); ls += p0[i] + p1[i]; }
                l = l * alpha + ls;
                if (__any(alpha != 1.f ? 1 : 0)) {
#pragma unroll
                    for (int i = 0; i < 16; ++i) { o0[i] *= alpha; o1[i] *= alpha; } }
#pragma unroll
                for (int sp = 0; sp < 4; ++sp) { const int blk = sp >> 1, s = sp & 1; u32x4 pw;
                    if (blk == 0) { pw.x = pk2(p0[8 * s], p0[8 * s + 1]); pw.y = pk2(p0[8 * s + 2], p0[8 * s + 3]); pw.z = pk2(p0[8 * s + 4], p0[8 * s + 5]); pw.w = pk2(p0[8 * s + 6], p0[8 * s + 7]); }
                    else { pw.x = pk2(p1[8 * s], p1[8 * s + 1]); pw.y = pk2(p1[8 * s + 2], p1[8 * s + 3]); pw.z = pk2(p1[8 * s + 4], p1[8 * s + 5]); pw.w = pk2(p1[8 * s + 6], p1[8 * s + 7]); }
                    const bf16x8 pf = __builtin_bit_cast(bf16x8, pw);
                    { const LAS unsigned char* vp = Vl + (32 * blk + 16 * s + 4 * hi + ((lane & 15) >> 2)) * 144 + (16 * ((lane >> 4) & 1) + 4 * (lane & 3)) * 2;
                      const bf16x8 vf0 = __builtin_shufflevector(vtr(vp), vtr(vp + 8 * 144), 0, 1, 2, 3, 4, 5, 6, 7); __builtin_amdgcn_s_setprio(1); o0 = MFMA32(vf0, pf, o0);
                      const bf16x8 vf1 = __builtin_shufflevector(vtr(vp + 64), vtr(vp + 64 + 8 * 144), 0, 1, 2, 3, 4, 5, 6, 7); o1 = MFMA32(vf1, pf, o1); __builtin_amdgcn_s_setprio(0); } }
            }
            bool need;
            if (FOXC) { need = causal_skip ? true : (active && kt > 0 && __any((qn * pkn + cq - c2n - m > -40.f) ? 1 : 0) != 0); if (!causal_skip) active = need; }
            else need = (64 * kt - 1 >= tw - 127);
            if (lane == 0) flags[par * 8 + wid] = need ? 1 : 0;
            LBAR();
            if (kt == kt_lo) break;
            int any = 0;
#pragma unroll
            for (int w = 0; w < 8; ++w) any |= flags[par * 8 + w];
            par ^= 1;
            if (!any) break;
        }
        const float lt = l + __shfl_xor(l, 32), inv = 1.f / lt;
        bf16_t* ob = c.buf + (size_t)qpos * c.ld + c.ooff + h * 64;
#pragma unroll
        for (int gp = 0; gp < 4; gp += 2) {
            u32x2 a0, b0, a1, b1;
            a0.x = pk2(o0[4 * gp] * inv, o0[4 * gp + 1] * inv); a0.y = pk2(o0[4 * gp + 2] * inv, o0[4 * gp + 3] * inv);
            b0.x = pk2(o0[4 * gp + 4] * inv, o0[4 * gp + 5] * inv); b0.y = pk2(o0[4 * gp + 6] * inv, o0[4 * gp + 7] * inv);
            a1.x = pk2(o1[4 * gp] * inv, o1[4 * gp + 1] * inv); a1.y = pk2(o1[4 * gp + 2] * inv, o1[4 * gp + 3] * inv);
            b1.x = pk2(o1[4 * gp + 4] * inv, o1[4 * gp + 5] * inv); b1.y = pk2(o1[4 * gp + 6] * inv, o1[4 * gp + 7] * inv);
            { auto r = __builtin_amdgcn_permlane32_swap(a0.x, b0.x, false, false); a0.x = r[0]; b0.x = r[1]; }
            { auto r = __builtin_amdgcn_permlane32_swap(a0.y, b0.y, false, false); a0.y = r[0]; b0.y = r[1]; }
            { auto r = __builtin_amdgcn_permlane32_swap(a1.x, b1.x, false, false); a1.x = r[0]; b1.x = r[1]; }
            { auto r = __builtin_amdgcn_permlane32_swap(a1.y, b1.y, false, false); a1.y = r[0]; b1.y = r[1]; }
            u32x4 s0; s0.x = a0.x; s0.y = a0.y; s0.z = b0.x; s0.w = b0.y; u32x4 s1; s1.x = a1.x; s1.y = a1.y; s1.z = b1.x; s1.w = b1.y;
            *(u32x4*)(ob + 8 * gp + 8 * hi) = s0; *(u32x4*)(ob + 32 + 8 * gp + 8 * hi) = s1; }
    }
}

__device__ __forceinline__ void swa_unit(int u, int nblk, int& kvh, int& qb) {
    if (nblk == 256) { const int it = u >> 8, b = u & 255, x = b & 7, j = it * 32 + (b >> 3); qb = 32 * x + (j >> 2); kvh = j & 3; }
    else { kvh = u & 3; qb = u >> 2; }
}
__device__ __forceinline__ void swa_phase(LAS unsigned char* lds, bf16_t* buf, const float* sinks, const int tid, const int bid, const int nblk) {
    const int lane = tid & 63, wid = __builtin_amdgcn_readfirstlane(tid >> 6), r32 = lane & 31, hi = lane >> 5;
    const int srow = tid >> 3, sch = tid & 7; const float NEG = -INFINITY;
    constexpr int LD = 4096, KOFF = 1024, VOFF = 1280, OOFF = 2048;
    u32x4 kp[3], vp[3];
#pragma unroll
    for (int j = 0; j < 3; ++j) { kp[j] = (u32x4){0u, 0u, 0u, 0u}; vp[j] = kp[j]; }
    bf16x8 qnx[4];
#pragma unroll
    for (int d0 = 0; d0 < 4; ++d0) qnx[d0] = (bf16x8){0, 0, 0, 0, 0, 0, 0, 0};
    if (bid < 1024) { int kvh, qb; swa_unit(bid, nblk, kvh, qb);
      { const bf16_t* qp0 = buf + (size_t)(64 * qb + 32 * (wid >> 2) + r32) * LD + (4 * kvh + (wid & 3)) * 64 + 8 * hi;
#pragma unroll
        for (int d0 = 0; d0 < 4; ++d0) qnx[d0] = *(const bf16x8*)(qp0 + 16 * d0); }
#pragma unroll
        for (int j = 0; j < 3; ++j) { const int kt = qb - 2 + j; if (kt >= 0) { const bf16_t* r = buf + (size_t)(64 * kt + srow) * LD + kvh * 64 + sch * 8; kp[j] = *(const u32x4*)(r + KOFF); vp[j] = *(const u32x4*)(r + VOFF); } } }
    for (int u = bid; u < 1024; u += nblk) {
        int kvh, qb; swa_unit(u, nblk, kvh, qb);
        const int h = 4 * kvh + (wid & 3), tw = 64 * qb + 32 * (wid >> 2), qpos = tw + r32;
#pragma unroll
        for (int j = 0; j < 3; ++j) { *(LAS u32x4*)(lds + j * 9216 + srow * 144 + sch * 16) = kp[j]; *(LAS u32x4*)(lds + 27648 + j * 9216 + srow * 144 + sch * 16) = vp[j]; }
        LBAR();
        { const int un = u + nblk; if (un < 1024) { int kvn, qn_; swa_unit(un, nblk, kvn, qn_);
#pragma unroll
            for (int j = 0; j < 3; ++j) { const int kt = qn_ - 2 + j; if (kt >= 0) { const bf16_t* r = buf + (size_t)(64 * kt + srow) * LD + kvn * 64 + sch * 8; kp[j] = *(const u32x4*)(r + KOFF); vp[j] = *(const u32x4*)(r + VOFF); } } } }
        bf16x8 qr[4];
#pragma unroll
        for (int d0 = 0; d0 < 4; ++d0) qr[d0] = qnx[d0];
        { const int un = u + nblk; if (un < 1024) { int kvq, qbq; swa_unit(un, nblk, kvq, qbq); const bf16_t* qpn = buf + (size_t)(64 * qbq + 32 * (wid >> 2) + r32) * LD + (4 * kvq + (wid & 3)) * 64 + 8 * hi;
#pragma unroll
            for (int d0 = 0; d0 < 4; ++d0) qnx[d0] = *(const bf16x8*)(qpn + 16 * d0); } }
        float m = sinks[h] * LOG2E, l = (hi == 0) ? 1.f : 0.f;
        f32x16 o0, o1;
#pragma unroll
        for (int i = 0; i < 16; ++i) { o0[i] = 0.f; o1[i] = 0.f; }
#pragma unroll
        for (int j = 2; j >= 0; --j) { const int kt = qb - 2 + j;
            if (kt >= 0 && 64 * kt + 63 >= tw - 127) {
                const LAS unsigned char* Kl = lds + j * 9216; const LAS unsigned char* Vl = lds + 27648 + j * 9216;
                f32x16 p0, p1;
#pragma unroll
                for (int i = 0; i < 16; ++i) { p0[i] = 0.f; p1[i] = 0.f; }
#pragma unroll
                for (int d0 = 0; d0 < 4; ++d0) { const bf16x8 a0 = *(const LAS bf16x8*)(Kl + r32 * 144 + d0 * 32 + hi * 16), a1 = *(const LAS bf16x8*)(Kl + (32 + r32) * 144 + d0 * 32 + hi * 16);
                    __builtin_amdgcn_s_setprio(1); p0 = MFMA32(a0, qr[d0], p0); p1 = MFMA32(a1, qr[d0], p1); __builtin_amdgcn_s_setprio(0); }
                const bool full = (64 * kt + 63 <= tw) && (tw + 31 - 64 * kt < 128);
                float rm = NEG;
                if (!full) {
                    const int dq = qpos - 64 * kt - 4 * hi;
#pragma unroll
                    for (int i = 0; i < 16; ++i) { const unsigned d0 = (unsigned)(dq - ((i & 3) + 8 * (i >> 2))), d1 = d0 - 32u;
                        p0[i] = (d0 < 128u) ? p0[i] : NEG; p1[i] = (d1 < 128u) ? p1[i] : NEG; } }
#pragma unroll
                for (int i = 0; i < 16; ++i) rm = fmaxf(rm, fmaxf(p0[i], p1[i]));
                rm = fmaxf(rm, __shfl_xor(rm, 32));
                float mn = m; if (__any((rm > m + 8.f) ? 1 : 0)) mn = fmaxf(m, rm);
                const float alpha = __builtin_amdgcn_exp2f(m - mn); m = mn;
                float ls = 0.f;
#pragma unroll
                for (int i = 0; i < 16; ++i) { p0[i] = __builtin_amdgcn_exp2f(p0[i] - mn); p1[i] = __builtin_amdgcn_exp2f(p1[i] - mn); ls += p0[i] + p1[i]; }
                l = l * alpha + ls;
                if (__any(alpha != 1.f ? 1 : 0)) {
#pragma unroll
                    for (int i = 0; i < 16; ++i) { o0[i] *= alpha; o1[i] *= alpha; } }
#pragma unroll
                for (int sp = 0; sp < 4; ++sp) { const int blk = sp >> 1, s = sp & 1; u32x4 pw;
                    if (blk == 0) { pw.x = pk2(p0[8 * s], p0[8 * s + 1]); pw.y = pk2(p0[8 * s + 2], p0[8 * s + 3]); pw.z = pk2(p0[8 * s + 4], p0[8 * s + 5]); pw.w = pk2(p0[8 * s + 6], p0[8 * s + 7]); }
                    else { pw.x = pk2(p1[8 * s], p1[8 * s + 1]); pw.y = pk2(p1[8 * s + 2], p1[8 * s + 3]); pw.z = pk2(p1[8 * s + 4], p1[8 * s + 5]); pw.w = pk2(p1[8 * s + 6], p1[8 * s + 7]); }
                    const bf16x8 pf = __builtin_bit_cast(bf16x8, pw);
                    const LAS unsigned char* vq = Vl + (32 * blk + 16 * s + 4 * hi + ((lane & 15) >> 2)) * 144 + (16 * ((lane >> 4) & 1) + 4 * (lane & 3)) * 2;
                    const bf16x8 vf0 = __builtin_shufflevector(vtr(vq), vtr(vq + 8 * 144), 0, 1, 2, 3, 4, 5, 6, 7); __builtin_amdgcn_s_setprio(1); o0 = MFMA32(vf0, pf, o0);
                    const bf16x8 vf1 = __builtin_shufflevector(vtr(vq + 64), vtr(vq + 64 + 8 * 144), 0, 1, 2, 3, 4, 5, 6, 7); o1 = MFMA32(vf1, pf, o1); __builtin_amdgcn_s_setprio(0); }
            } }
        const float lt = l + __shfl_xor(l, 32), inv = 1.f / lt;
        bf16_t* ob = buf + (size_t)qpos * LD + OOFF + h * 64;
#pragma unroll
        for (int gp = 0; gp < 4; gp += 2) {
            u32x2 a0, b0, a1, b1;
            a0.x = pk2(o0[4 * gp] * inv, o0[4 * gp + 1] * inv); a0.y = pk2(o0[4 * gp + 2] * inv, o0[4 * gp + 3] * inv);
            b0.x = pk2(o0[4 * gp + 4] * inv, o0[4 * gp + 5] * inv); b0.y = pk2(o0[4 * gp + 6] * inv, o0[4 * gp + 7] * inv);
            a1.x = pk2(o1[4 * gp] * inv, o1[4 * gp + 1] * inv); a1.y = pk2(o1[4 * gp + 2] * inv, o1[4 * gp + 3] * inv);
            b1.x = pk2(o1[4 * gp + 4] * inv, o1[4 * gp + 5] * inv); b1.y = pk2(o1[4 * gp + 6] * inv, o1[4 * gp + 7] * inv);
            { auto r = __builtin_amdgcn_permlane32_swap(a0.x, b0.x, false, false); a0.x = r[0]; b0.x = r[1]; }
            { auto r = __builtin_amdgcn_permlane32_swap(a0.y, b0.y, false, false); a0.y = r[0]; b0.y = r[1]; }
            { auto r = __builtin_amdgcn_permlane32_swap(a1.x, b1.x, false, false); a1.x = r[0]; b1.x = r[1]; }
            { auto r = __builtin_amdgcn_permlane32_swap(a1.y, b1.y, false, false); a1.y = r[0]; b1.y = r[1]; }
            u32x4 s0; s0.x = a0.x; s0.y = a0.y; s0.z = b0.x; s0.w = b0.y; u32x4 s1; s1.x = a1.x; s1.y = a1.y; s1.z = b1.x; s1.w = b1.y;
            *(u32x4*)(ob + 8 * gp + 8 * hi) = s0; *(u32x4*)(ob + 32 + 8 * gp + 8 * hi) = s1; }
        LBAR();
    }
}

__device__ __forceinline__ void fox_flog(PP p, const float* ssq, const float* bias, int gw, int ngw, int lane) {
    const bf16_t* XB = (const bf16_t*)(p->ws + WS_XB); const bf16_t* WF = (const bf16_t*)(p->ws + WS_WMIX) + 4096 * 1024; float* LF = (float*)(p->ws + WS_LF);
    const int fr = lane & 15, q = lane >> 4;
    for (int tl = gw; tl < T / 16; tl += ngw) { const int t0 = 16 * tl; f32x4 acc = {0.f, 0.f, 0.f, 0.f};
        const bf16_t* ap = XB + (size_t)(t0 + fr) * 1024 + 8 * q; const bf16_t* bp = WF + (size_t)fr * 1024 + 8 * q;
#pragma unroll 8
        for (int ks = 0; ks < 32; ++ks) acc = MFMA16(*(const bf16x8*)(ap + 32 * ks), *(const bf16x8*)(bp + 32 * ks), acc);
        const float bb = bias[fr];
#pragma unroll
        for (int j = 0; j < 4; ++j) { const int t = t0 + 4 * q + j; const float rs = row_rstd(ssq, t); const float v = acc[j] * rs + bb;
            const float ls = (v < 0.f) ? (v - log1pf(__expf(v))) : -log1pf(__expf(-v)); LF[(size_t)t * 16 + fr] = ls * LOG2E; } }
}
__device__ __forceinline__ void fox_scan(LAS unsigned char* lds, PP p, const int tid, const int bid, const int nblk) {
    const int lane = tid & 63, wid = tid >> 6;
    const float* LF = (const float*)(p->ws + WS_LF); float* C2 = (float*)(p->ws + WS_C2); float* PK = (float*)(p->ws + WS_PK); float* SEG = (float*)(p->ws + WS_SEG);
    LAS float* ws_sum = (LAS float*)lds; LAS float* ws_max = ws_sum + 8;
    for (int u = bid; u < 256; u += nblk) { const int h = u & 15, sg = u >> 4, t0 = sg * 1024 + 2 * tid;
        const bf16_t* KB = (const bf16_t*)(p->ws + WS_BIG) + 1024 + h * 64 + (size_t)t0 * 4096;
        u32x4 ka[8], kb[8];
#pragma unroll
        for (int c = 0; c < 8; ++c) { ka[c] = *(const u32x4*)(KB + 8 * c); kb[c] = *(const u32x4*)(KB + 4096 + 8 * c); }
        const float l0 = LF[(size_t)t0 * 16 + h], l1 = LF[(size_t)(t0 + 1) * 16 + h];
        float n0 = 0.f, n1 = 0.f;
#pragma unroll
        for (int c = 0; c < 8; ++c)
#pragma unroll
            for (int e = 0; e < 8; ++e) { const float f0 = bf_get(ka[c], e), f1 = bf_get(kb[c], e); n0 += f0 * f0; n1 += f1 * f1; }
        const float s = l0 + l1, mx = fmaxf(n0, n1);
        float is = s, im = mx;
#pragma unroll
        for (int o = 1; o < 64; o <<= 1) { const float a = __shfl_up(is, o), b = __shfl_up(im, o); if (lane >= o) { is += a; im = fmaxf(im, b); } }
        if (lane == 63) { ws_sum[wid] = is; ws_max[wid] = im; }
        __syncthreads();
        float es = is - s, em = __shfl_up(im, 1); if (lane == 0) em = 0.f;
        for (int w = 0; w < wid; ++w) { es += ws_sum[w]; em = fmaxf(em, ws_max[w]); }
        const float m0 = fmaxf(em, n0), m1 = fmaxf(m0, n1);
        C2[(size_t)h * T + t0] = es + l0; C2[(size_t)h * T + t0 + 1] = (es + l0) + l1;
        PK[(size_t)h * T + t0] = sqrtf(m0) * 1.0001f; PK[(size_t)h * T + t0 + 1] = sqrtf(m1) * 1.0001f;
        if (tid == NTHR - 1) { SEG[h * 16 + sg] = (es + l0) + l1; SEG[256 + h * 16 + sg] = sqrtf(m1) * 1.0001f; }
        __syncthreads();
    }
}
__device__ __forceinline__ void hgrn_x1(LAS unsigned char* lds, PP p, int layer, const int tid, const int bid, const int nblk) {
    bf16_t* PB = (bf16_t*)(p->ws + WS_BIG); float* DS = (float*)(p->ws + WS_DS); float* DSEG = (float*)(p->ws + WS_DSEG); const float* lbl = p->in[11];
    LAS float* LF = (LAS float*)lds;
    LAS float* GT = (LAS float*)(lds + 16896);
    LAS float* BP = (LAS float*)(lds + 18944);
    LAS float* ED = (LAS float*)(lds + 19456);
    LAS float* LB = (LAS float*)(lds + 19968);
    LAS unsigned char* QT = lds + 20480;
    LAS unsigned char* KT = lds + 29184;
    LAS unsigned char* KH = lds + 37888;
    LAS unsigned char* VT = lds + 46592;
    const int lane = tid & 63, wid = __builtin_amdgcn_readfirstlane(tid >> 6), fr = lane & 15, q = lane >> 4;
    const int pt = tid >> 4, kg = tid & 15, ck = tid & 127, ctg = tid >> 7;
    for (int u = bid; u < 256; u += nblk) {
        const int h = u >> 5, sg = u & 31, row0 = sg * 512;
        if (tid < 128) { const int kk = h * 128 + tid; const float a0 = lbl[kk], a1 = lbl[1024 + kk], a2 = lbl[2048 + kk], a3 = lbl[3072 + kk];
            const float mx = fmaxf(fmaxf(a0, a1), fmaxf(a2, a3)); const float e0 = __expf(a0 - mx), e1 = __expf(a1 - mx), e2 = __expf(a2 - mx), e3 = __expf(a3 - mx);
            float lbv = 0.f; if (layer >= 1) lbv += e1; if (layer >= 2) lbv += e2; if (layer >= 3) lbv += e3;
            LB[tid] = lbv / (e0 + e1 + e2 + e3); BP[tid] = 0.f; }
        f32x4 S[8];
#pragma unroll
        for (int i = 0; i < 8; ++i) S[i] = (f32x4){0.f, 0.f, 0.f, 0.f};
        u32x4 nq, nz, nv;
        { const bf16_t* nb = PB + (size_t)(row0 + pt) * 4096 + h * 128 + 8 * kg; nq = *(const u32x4*)nb; nz = *(const u32x4*)(nb + 1024); nv = *(const u32x4*)(nb + 2048); }
        __syncthreads();
        for (int c = 0; c < 16; ++c) {
            const int crow0 = row0 + 32 * c;
            bf16_t* base = PB + (size_t)(crow0 + pt) * 4096 + h * 128 + 8 * kg;
            const u32x4 qv = nq, zv = nz, vv = nv;
            if (c + 1 < 16) { const bf16_t* nb = base + (size_t)32 * 4096; nq = *(const u32x4*)nb; nz = *(const u32x4*)(nb + 1024); nv = *(const u32x4*)(nb + 2048); }
            float fk[8], qs[8], blast[8];
            const f32x4 lbA = *(const LAS f32x4*)(LB + 8 * kg), lbB = *(const LAS f32x4*)(LB + 8 * kg + 4);
#pragma unroll
            for (int i = 0; i < 8; ++i) { const float z = bf_get(zv, i), lb = (i < 4) ? lbA[i & 3] : lbB[i & 3]; const float sgm = 1.f / (1.f + __expf(-z)); const float f = lb + (1.f - lb) * sgm;
                LF[pt * 132 + 8 * kg + i] = __logf(f); fk[i] = 1.f - f; qs[i] = bf_get(qv, i); }
            LBAR();
            { float run = 0.f;
#pragma unroll
              for (int tt = 0; tt < 8; ++tt) { const int a = (8 * ctg + tt) * 132 + ck; run += LF[a]; LF[a] = run; }
              GT[ctg * 128 + ck] = run; }
            LBAR();
            { const int tgp = pt >> 3; float qt[8], ktv[8], qg[8], khv[8];
              f32x4 gA[4], gB[4];
#pragma unroll
              for (int g = 0; g < 4; ++g) { gA[g] = *(const LAS f32x4*)(GT + g * 128 + 8 * kg); gB[g] = *(const LAS f32x4*)(GT + g * 128 + 8 * kg + 4); }
              const f32x4 lfA = *(const LAS f32x4*)(LF + pt * 132 + 8 * kg), lfB = *(const LAS f32x4*)(LF + pt * 132 + 8 * kg + 4);
              const f32x4 bpA = *(const LAS f32x4*)(BP + 8 * kg), bpB = *(const LAS f32x4*)(BP + 8 * kg + 4);
#pragma unroll
              for (int i = 0; i < 8; ++i) { const int k = 8 * kg + i; const int e = i & 3;
                  const float g0 = (i < 4) ? gA[0][e] : gB[0][e], g1 = (i < 4) ? gA[1][e] : gB[1][e], g2 = (i < 4) ? gA[2][e] : gB[2][e], g3 = (i < 4) ? gA[3][e] : gB[3][e];
                  const float pre = (tgp > 0 ? g0 : 0.f) + (tgp > 1 ? g1 : 0.f) + (tgp > 2 ? g2 : 0.f); const float bl = (g0 + g1) + (g2 + g3);
                  const float b = ((i < 4) ? lfA[e] : lfB[e]) + pre; const float Bp = (i < 4) ? bpA[e] : bpB[e];
                  qt[i] = qs[i] * __expf(b); ktv[i] = fk[i] * __expf(fminf(-b, 80.f)); khv[i] = fk[i] * __expf(bl - b); qg[i] = qs[i] * __expf(Bp + b);
                  blast[i] = bl; if (pt == 31) ED[k] = __expf(bl); }
              u32x4 w; w.x = pk2(qt[0], qt[1]); w.y = pk2(qt[2], qt[3]); w.z = pk2(qt[4], qt[5]); w.w = pk2(qt[6], qt[7]); *(LAS u32x4*)(QT + pt * 272 + kg * 16) = w;
              w.x = pk2(ktv[0], ktv[1]); w.y = pk2(ktv[2], ktv[3]); w.z = pk2(ktv[4], ktv[5]); w.w = pk2(ktv[6], ktv[7]); *(LAS u32x4*)(KT + pt * 272 + kg * 16) = w;
              w.x = pk2(khv[0], khv[1]); w.y = pk2(khv[2], khv[3]); w.z = pk2(khv[4], khv[5]); w.w = pk2(khv[6], khv[7]); *(LAS u32x4*)(KH + pt * 272 + kg * 16) = w;
              *(LAS u32x4*)(VT + pt * 272 + kg * 16) = vv;
              w.x = pk2(qg[0], qg[1]); w.y = pk2(qg[2], qg[3]); w.z = pk2(qg[4], qg[5]); w.w = pk2(qg[6], qg[7]); *(u32x4*)base = w; }
            LBAR();
            if (pt == 31) {
#pragma unroll
                for (int i = 0; i < 8; ++i) BP[8 * kg + i] += blast[i]; }
            { f32x4 AT00 = {0.f, 0.f, 0.f, 0.f}, AT01 = AT00, AT11 = AT00;
#pragma unroll
              for (int ks = 0; ks < 4; ++ks) { const bf16x8 a0 = *(const LAS bf16x8*)(KT + fr * 272 + ks * 64 + q * 16), a1 = *(const LAS bf16x8*)(KT + (16 + fr) * 272 + ks * 64 + q * 16);
                  const bf16x8 b0 = *(const LAS bf16x8*)(QT + fr * 272 + ks * 64 + q * 16), b1 = *(const LAS bf16x8*)(QT + (16 + fr) * 272 + ks * 64 + q * 16);
                  AT00 = MFMA16(a0, b0, AT00); AT01 = MFMA16(a0, b1, AT01); AT11 = MFMA16(a1, b1, AT11); }
#pragma unroll
              for (int j = 0; j < 4; ++j) if (4 * q + j > fr) { AT00[j] = 0.f; AT11[j] = 0.f; }
              u32x4 w0, w1; w0.x = pk2(AT00[0], AT00[1]); w0.y = pk2(AT00[2], AT00[3]); w0.z = 0u; w0.w = 0u;
              w1.x = pk2(AT01[0], AT01[1]); w1.y = pk2(AT01[2], AT01[3]); w1.z = pk2(AT11[0], AT11[1]); w1.w = pk2(AT11[2], AT11[3]);
              const bf16x8 Bp0 = __builtin_bit_cast(bf16x8, w0), Bp1 = __builtin_bit_cast(bf16x8, w1);
              const LAS unsigned char* vcol = VT + (fr >> 2) * 272 + (16 * wid + 4 * (fr & 3)) * 2;
              const bf16x8 va = __builtin_shufflevector(vtr(vcol + (4 * q) * 272), vtr(vcol + (16 + 4 * q) * 272), 0, 1, 2, 3, 4, 5, 6, 7);
              const f32x4 zero4 = {0.f, 0.f, 0.f, 0.f};
              f32x4 oT0 = MFMA16(va, Bp0, zero4), oT1 = MFMA16(va, Bp1, zero4);
#pragma unroll
              for (int kk = 0; kk < 4; ++kk) { u32x4 sw; sw.x = pk2(S[2 * kk][0], S[2 * kk][1]); sw.y = pk2(S[2 * kk][2], S[2 * kk][3]); sw.z = pk2(S[2 * kk + 1][0], S[2 * kk + 1][1]); sw.w = pk2(S[2 * kk + 1][2], S[2 * kk + 1][3]);
                  const bf16x8 sa = __builtin_bit_cast(bf16x8, sw);
                  const LAS unsigned char* q0p = QT + fr * 272 + kk * 64 + q * 8; const LAS unsigned char* q1p = q0p + 16 * 272;
                  const bf16x8 qb0 = __builtin_shufflevector(*(const LAS s16x4*)q0p, *(const LAS s16x4*)(q0p + 32), 0, 1, 2, 3, 4, 5, 6, 7);
                  const bf16x8 qb1 = __builtin_shufflevector(*(const LAS s16x4*)q1p, *(const LAS s16x4*)(q1p + 32), 0, 1, 2, 3, 4, 5, 6, 7);
                  oT0 = MFMA16(sa, qb0, oT0); oT1 = MFMA16(sa, qb1, oT1); }
              { bf16_t* op = PB + (size_t)(crow0 + fr) * 4096 + 1024 + h * 128 + 16 * wid + 4 * q; u32x2 w; w.x = pk2(oT0[0], oT0[1]); w.y = pk2(oT0[2], oT0[3]); *(u32x2*)op = w;
                w.x = pk2(oT1[0], oT1[1]); w.y = pk2(oT1[2], oT1[3]); *(u32x2*)(op + (size_t)16 * 4096) = w; }
              const bf16x8 vb = __builtin_shufflevector(vtr(vcol + (8 * q) * 272), vtr(vcol + (8 * q + 4) * 272), 0, 1, 2, 3, 4, 5, 6, 7);
#pragma unroll
              for (int kt = 0; kt < 8; ++kt) { const LAS unsigned char* kc = KH + (8 * q + (fr >> 2)) * 272 + (16 * kt + 4 * (fr & 3)) * 2;
                  const bf16x8 ka = __builtin_shufflevector(vtr(kc), vtr(kc + 4 * 272), 0, 1, 2, 3, 4, 5, 6, 7); const f32x4 ed = *(const LAS f32x4*)(ED + 16 * kt + 4 * q);
                  S[kt] = MFMA16(ka, vb, S[kt] * ed); } }
        }
#pragma unroll
        for (int kt = 0; kt < 8; ++kt)
#pragma unroll
            for (int j = 0; j < 4; ++j) DS[((size_t)u * 128 + 16 * kt + 4 * q + j) * 128 + 16 * wid + fr] = S[kt][j];
        __syncthreads();
        if (tid < 128) DSEG[u * 128 + tid] = __expf(BP[tid]);
        __syncthreads();
    }
}
__device__ __forceinline__ void hgrn_x3(LAS unsigned char* lds, PP p, const float* gnorm, const int tid, const int bid, const int nblk) {
    bf16_t* PB = (bf16_t*)(p->ws + WS_BIG); const float* DS = (const float*)(p->ws + WS_DS); const float* DSEG = (const float*)(p->ws + WS_DSEG);
    LAS unsigned char* ST = lds;
    const int lane = tid & 63, wid = __builtin_amdgcn_readfirstlane(tid >> 6), fr = lane & 15, q = lane >> 4;
    for (int u = bid; u < 256; u += nblk) {
        const int h = u >> 5, sg = u & 31, row0 = sg * 512;
        { const int k = tid & 127, vg = tid >> 7; float acc[32];
#pragma unroll
          for (int i = 0; i < 32; ++i) acc[i] = 0.f;
          float P = 1.f;
          for (int j = sg - 1; j >= 0; --j) { const f32x4* src = (const f32x4*)(DS + ((size_t)((h * 32 + j) * 128 + k)) * 128 + 32 * vg);
#pragma unroll
              for (int i = 0; i < 8; ++i) { const f32x4 v = src[i]; acc[4 * i] += P * v[0]; acc[4 * i + 1] += P * v[1]; acc[4 * i + 2] += P * v[2]; acc[4 * i + 3] += P * v[3]; }
              P *= DSEG[(h * 32 + j) * 128 + k];
              if (!__syncthreads_or(P != 0.f ? 1 : 0)) break; }
#pragma unroll
          for (int i = 0; i < 32; ++i) *(LAS bf16_t*)(ST + (32 * vg + i) * 272 + k * 2) = (bf16_t)(pk2(acc[i], 0.f) & 0xffffu); }
        __syncthreads();
        bf16x8 bqn[4]; u32x4 oln[4], gvn[4];
        { const bf16_t* rp = PB + (size_t)(row0 + 64 * wid + fr) * 4096 + h * 128;
#pragma unroll
          for (int kk = 0; kk < 4; ++kk) bqn[kk] = *(const bf16x8*)(rp + 32 * kk + 8 * q);
#pragma unroll
          for (int pp = 0; pp < 4; ++pp) { oln[pp] = *(const u32x4*)(rp + 1024 + 32 * pp + 8 * q); gvn[pp] = *(const u32x4*)(rp + 3072 + 32 * pp + 8 * q); } }
#pragma unroll
        for (int tb = 0; tb < 4; ++tb) { const int t = row0 + 64 * wid + 16 * tb + fr; bf16_t* rowp = PB + (size_t)t * 4096 + h * 128;
            bf16x8 bq[4]; u32x4 olv[4], gvv[4];
#pragma unroll
            for (int kk = 0; kk < 4; ++kk) bq[kk] = bqn[kk];
#pragma unroll
            for (int pp = 0; pp < 4; ++pp) { olv[pp] = oln[pp]; gvv[pp] = gvn[pp]; }
            if (tb < 3) { const bf16_t* rp = rowp + (size_t)16 * 4096;
#pragma unroll
                for (int kk = 0; kk < 4; ++kk) bqn[kk] = *(const bf16x8*)(rp + 32 * kk + 8 * q);
#pragma unroll
                for (int pp = 0; pp < 4; ++pp) { oln[pp] = *(const u32x4*)(rp + 1024 + 32 * pp + 8 * q); gvn[pp] = *(const u32x4*)(rp + 3072 + 32 * pp + 8 * q); } }
            f32x4 oT[8];
#pragma unroll
            for (int vt = 0; vt < 8; ++vt) oT[vt] = (f32x4){0.f, 0.f, 0.f, 0.f};
            if (sg > 0) {
#pragma unroll
                for (int kk = 0; kk < 4; ++kk) {
#pragma unroll
                    for (int vt = 0; vt < 8; ++vt) { const int vrow = 32 * (vt >> 1) + 8 * (fr >> 2) + 4 * (vt & 1) + (fr & 3);
                        const bf16x8 sa = *(const LAS bf16x8*)(ST + vrow * 272 + kk * 64 + q * 16); oT[vt] = MFMA16(sa, bq[kk], oT[vt]); } } }
            float ss = 0.f;
#pragma unroll
            for (int pp = 0; pp < 4; ++pp) { const u32x4 ol = olv[pp];
                oT[2 * pp][0] += bf_lo(ol.x); oT[2 * pp][1] += bf_hi(ol.x); oT[2 * pp][2] += bf_lo(ol.y); oT[2 * pp][3] += bf_hi(ol.y);
                oT[2 * pp + 1][0] += bf_lo(ol.z); oT[2 * pp + 1][1] += bf_hi(ol.z); oT[2 * pp + 1][2] += bf_lo(ol.w); oT[2 * pp + 1][3] += bf_hi(ol.w); }
#pragma unroll
            for (int vt = 0; vt < 8; ++vt) ss += (oT[vt][0] * oT[vt][0] + oT[vt][1] * oT[vt][1]) + (oT[vt][2] * oT[vt][2] + oT[vt][3] * oT[vt][3]);
            ss += __shfl_xor(ss, 16); ss += __shfl_xor(ss, 32);
            const float rstd = rsqrtf(ss * (1.f / 128.f) + EPS);
#pragma unroll
            for (int pp = 0; pp < 4; ++pp) { const u32x4 gv = gvv[pp]; const f32x4 g0 = *(const f32x4*)(gnorm + h * 128 + 32 * pp + 8 * q), g1 = *(const f32x4*)(gnorm + h * 128 + 32 * pp + 8 * q + 4);
                u32x4 w;
                w.x = pk2(oT[2 * pp][0] * rstd * g0[0] * bf_lo(gv.x), oT[2 * pp][1] * rstd * g0[1] * bf_hi(gv.x)); w.y = pk2(oT[2 * pp][2] * rstd * g0[2] * bf_lo(gv.y), oT[2 * pp][3] * rstd * g0[3] * bf_hi(gv.y));
                w.z = pk2(oT[2 * pp + 1][0] * rstd * g1[0] * bf_lo(gv.z), oT[2 * pp + 1][1] * rstd * g1[1] * bf_hi(gv.z)); w.w = pk2(oT[2 * pp + 1][2] * rstd * g1[2] * bf_lo(gv.w), oT[2 * pp + 1][3] * rstd * g1[3] * bf_hi(gv.w));
                *(u32x4*)(rowp + 2048 + 32 * pp + 8 * q) = w; } }
        __syncthreads();
    }
}

#ifndef PHASE_TABLE
#define PHASE_TABLE
constexpr int NPHASE = 24;
__constant__ unsigned char PH_KIND[NPHASE] = {0, 1, 2, 6, 7, 8, 1, 3, 4, 6, 7, 8, 1, 5, 2, 6, 7, 8, 1, 2, 6, 7, 8, 9};
__constant__ unsigned char PH_L[NPHASE]    = {0, 0, 0, 0, 0, 0, 1, 1, 1, 1, 1, 1, 2, 2, 2, 2, 2, 2, 3, 3, 3, 3, 3, 3};
#endif
__global__ void __launch_bounds__(NTHR, 2) fwd_megakernel(Params p_unused) {
    extern __shared__ __attribute__((aligned(16))) unsigned char lds_raw[];
    LAS unsigned char* lds = (LAS unsigned char*)lds_raw;
    cg::grid_group grid = cg::this_grid();
    { PP p0 = (PP)__builtin_amdgcn_kernarg_segment_ptr(); if (threadIdx.x < 16) ((LAS unsigned*)(lds + LDS_CTL))[threadIdx.x] = 0u; __syncthreads();
      (void)xcd_barrier_post((unsigned*)(p0->ws + WS_BAR), (volatile LAS unsigned*)(lds + LDS_CTL)); }
    for (int ph = 0; ph < NPHASE; ++ph) {
        PP p = (PP)__builtin_amdgcn_kernarg_segment_ptr(); asm volatile("" : "+s"(p));
        const int kind = PH_KIND[ph], L = PH_L[ph], mix = L % 3, jx = L / 3;
        int tid = threadIdx.x, bid = blockIdx.x, nblk = gridDim.x; asm volatile("" : "+v"(tid), "+s"(bid), "+s"(nblk));
        const int lane = tid & 63, wave = __builtin_amdgcn_readfirstlane(tid >> 6);
        const int gw = bid * NWV + wave, ngw = nblk * NWV;
        LAS float* scr = (LAS float*)(lds + wave * CONV_SCR_BYTES);
        bf16_t* BIG = (bf16_t*)(p->ws + WS_BIG); bf16_t* XB = (bf16_t*)(p->ws + WS_XB); bf16_t* WMIX = (bf16_t*)(p->ws + WS_WMIX); bf16_t* WMLP = (bf16_t*)(p->ws + WS_WMLP);
        float* SSQ = (float*)(p->ws + WS_SSQ);
        if (kind == 0) {
            conv_mix(p, 0, scr, gw, ngw, lane);
            { f32x4 nv[4] = {{0.f, 0.f, 0.f, 0.f}, {0.f, 0.f, 0.f, 0.f}, {0.f, 0.f, 0.f, 0.f}, {0.f, 0.f, 0.f, 0.f}};
              if (gw < T) { const f32x4* xr = (const f32x4*)(p->in[0] + (size_t)gw * D) + lane;
#pragma unroll
                  for (int j = 0; j < 4; ++j) nv[j] = __builtin_nontemporal_load(xr + 64 * j); }
              for (int m = gw; m < T; m += ngw) { f32x4 v[4]; float s = 0.f;
#pragma unroll
                  for (int j = 0; j < 4; ++j) v[j] = nv[j];
                  if (m + ngw < T) { const f32x4* xr = (const f32x4*)(p->in[0] + (size_t)(m + ngw) * D) + lane;
#pragma unroll
                      for (int j = 0; j < 4; ++j) nv[j] = __builtin_nontemporal_load(xr + 64 * j); }
#pragma unroll
                  for (int j = 0; j < 4; ++j) s += (v[j][0] * v[j][0] + v[j][1] * v[j][1]) + (v[j][2] * v[j][2] + v[j][3] * v[j][3]);
                  s = wave_sum(s); if (lane < 16) SSQ[(size_t)m * 16 + lane] = (lane == 0) ? s : 0.f;
                  u32x2* o = (u32x2*)(XB + (size_t)m * D) + lane;
#pragma unroll
                  for (int j = 0; j < 4; ++j) { u32x2 w; w.x = pk2(v[j][0], v[j][1]); w.y = pk2(v[j][2], v[j][3]); o[64 * j] = w; } } }
        } else if (kind == 1 || kind == 7) {
            if (kind == 7 && L < 3) { conv_mix(p, L + 1, scr, gw, ngw, lane); __syncthreads(); }
            if (kind == 1 && mix == 0) {
                const int lo = (384 - nblk > 0 && 384 - nblk < nblk) ? 384 - nblk : 0;
                if (bid >= lo) conv_mlp(p, L, scr, (bid - lo) * NWV + wave, (nblk - lo) * NWV, lane);
                __syncthreads(); }
            if (kind == 1 && mix == 2) fox_flog(p, SSQ + (size_t)(2 * L) * T * 16, p->in[15] + jx * 3088 + 3072, gw, ngw, lane);
            const float* sq = SSQ + (size_t)((kind == 7) ? 2 * L + 1 : 2 * L) * T * 16;
            const int ncols = (kind == 7 || mix == 1) ? 4096 : (mix == 0 ? 1536 : 3072);
            int pmc = -1;
            { const int nN = ncols / 256, nwg = 64 * nN; if (bid < nwg) { const int qq = nwg / 8, rr = nwg % 8, xcd = bid % 8, off = bid / 8;
                const int wgid = (xcd < rr ? xcd * (qq + 1) : rr * (qq + 1) + (xcd - rr) * qq) + off; const int nig = 8 * nN, fm = (wgid / nig) * 8, gsz = (64 - fm) < 8 ? (64 - fm) : 8;
                pmc = fm + ((wgid % nig) % gsz); } }
            LAS float* rsl = (LAS float*)(lds + 131072);
            if (tid < 256 && pmc >= 0) rsl[tid] = row_rstd(sq, pmc * 256 + tid);
            __syncthreads();
            if (kind == 7 || mix == 1) { pg8::EpiAct E;
                if (kind == 7) E = pg8::EpiAct{BIG, nullptr, sq, 0x55555555u  , 0, 1.f, rsl, pmc};
                else E = pg8::EpiAct{BIG, nullptr, sq, 0xAA0000AAu  , 0, 1.f, rsl, pmc};
                run_gemm<pg8::EpiAct, 4096, 1024, 1024>(lds, XB, (kind == 7) ? WMLP : WMIX, E, tid, bid, nblk); }
            else if (mix == 0) { pg8::EpiAct E{BIG, p->in[7] + jx * 1536, sq, 0u, 4, 0.125f * LOG2E, rsl, pmc}; run_gemm<pg8::EpiAct, 1536, 1024, 1024>(lds, XB, WMIX, E, tid, bid, nblk); }
            else { pg8::EpiAct E{BIG, p->in[15] + jx * 3088, sq, 0u, 4, 0.125f * LOG2E, rsl, pmc}; run_gemm<pg8::EpiAct, 3072, 1024, 1024>(lds, XB, WMIX, E, tid, bid, nblk); }
        } else if (kind == 6 || kind == 8) {
            pg8::EpiResid E; const bf16_t* A; const bf16_t* Bt;
            if (kind == 8) { E = pg8::EpiResid{XB, SSQ + (size_t)(2 * L + 2) * T * 16}; run_gemm<pg8::EpiResid, 1024, 4096, 4096>(lds, BIG, WMLP + 4096 * 1024, E, tid, bid, nblk); }
            else { E = pg8::EpiResid{XB, SSQ + (size_t)(2 * L + 1) * T * 16};
                if (mix == 0) { A = BIG + 2048; Bt = WMIX + 1536 * 1024; } else if (mix == 1) { A = BIG + 2048; Bt = WMIX + 4096 * 1024; } else { A = BIG + 3072; Bt = WMIX + 3072 * 1024; }
                run_gemm<pg8::EpiResid, 1024, 1024, 4096>(lds, A, Bt, E, tid, bid, nblk); }
        } else if (kind == 2) {
            if (mix != 0) { conv_mlp(p, L, scr, gw, ngw, lane); __syncthreads(); }
            if (mix == 0) swa_phase(lds, BIG, p->in[8] + jx * 16, tid, bid, nblk);
            else { AttnCfg c{BIG, 4096, 1024, 2048, 3072, 1, nullptr, (const float*)(p->ws + WS_C2), (const float*)(p->ws + WS_PK), (const float*)(p->ws + WS_SEG)}; attn_phase(lds, c, tid, bid, nblk); }
        } else if (kind == 3) {
            conv_mlp(p, L, scr, gw, ngw, lane); __syncthreads();
            hgrn_x1(lds, p, L, tid, bid, nblk);
        } else if (kind == 4) {
            hgrn_x3(lds, p, p->in[12] + jx * 1024, tid, bid, nblk);
        } else if (kind == 5) {
            fox_scan(lds, p, tid, bid, nblk);
        } else if (kind == 9) {
            const float* ssq = SSQ + (size_t)8 * T * 16; const float* gf = p->in[3];
            { u32x2 nb[4] = {{0u, 0u}, {0u, 0u}, {0u, 0u}, {0u, 0u}}; float nrs = 0.f;
              if (gw < T) { const u32x2* xs = (const u32x2*)(XB + (size_t)gw * D) + lane; nrs = row_rstd(ssq, gw);
#pragma unroll
                  for (int j = 0; j < 4; ++j) nb[j] = xs[64 * j]; }
              for (int m = gw; m < T; m += ngw) { f32x4* xr = (f32x4*)(p->out + (size_t)m * D) + lane; u32x2 b[4]; const float rs = nrs;
#pragma unroll
                  for (int j = 0; j < 4; ++j) b[j] = nb[j];
                  if (m + ngw < T) { const u32x2* xs = (const u32x2*)(XB + (size_t)(m + ngw) * D) + lane; nrs = row_rstd(ssq, m + ngw);
#pragma unroll
                      for (int j = 0; j < 4; ++j) nb[j] = xs[64 * j]; }
#pragma unroll
                  for (int j = 0; j < 4; ++j) { const f32x4 g = *((const f32x4*)gf + lane + 64 * j);
                      f32x4 v = {bf_lo(b[j].x), bf_hi(b[j].x), bf_lo(b[j].y), bf_hi(b[j].y)}; v = v * rs * g; __builtin_nontemporal_store(v, xr + 64 * j); } } }
        }
        if (ph + 1 < NPHASE) {
            if (p->ws == nullptr) {
                grid.sync();
            } else {
                XcdBarrier xb; xb.bar = (unsigned*)(p->ws + WS_BAR); xb.x = xb_xcc_id(); xb.st = (volatile LAS unsigned*)(lds + LDS_CTL);
                xcd_barrier(xb);
            }
        }
    }
}

extern "C" void kernel_launch(void* const* d_in, const int* in_sizes, int n_in, void* d_out, int out_size, void* d_ws, size_t ws_size, hipStream_t stream) {
    static int grid_blocks = 0;
    if (grid_blocks == 0) {
        if (n_in != 17 || out_size != T * D || ws_size < WS_END) { fprintf(stderr, "kernel_launch: unexpected shapes (n_in %d out %d ws %zu)\n", n_in, out_size, ws_size); grid_blocks = -1; return; }
        int dev = 0, cus = 0, per_cu = 0;
        (void)hipGetDevice(&dev); (void)hipDeviceGetAttribute(&cus, hipDeviceAttributeMultiprocessorCount, dev);
        (void)hipFuncSetAttribute((const void*)fwd_megakernel, hipFuncAttributeMaxDynamicSharedMemorySize, LDS_BYTES);
        (void)hipOccupancyMaxActiveBlocksPerMultiprocessor(&per_cu, (const void*)fwd_megakernel, NTHR, LDS_BYTES);
        if (per_cu < 1) per_cu = 1;
        grid_blocks = cus * 1;
        (void)hipGetLastError();
    }
    if (grid_blocks < 0) return;
    (void)hipMemsetAsync((char*)d_ws + WS_BAR, 0, 16384, stream);
    Params p{};
    for (int i = 0; i < 17; ++i) p.in[i] = (const float*)d_in[i];
    p.out = (float*)d_out; p.ws = (unsigned char*)d_ws;
    void* args[] = {&p};
    hipError_t e = hipLaunchCooperativeKernel((const void*)fwd_megakernel, dim3(grid_blocks), dim3(NTHR), args, LDS_BYTES, stream);
    if (e != hipSuccess) fprintf(stderr, "cooperative launch failed: %s (grid %d)\n", hipGetErrorString(e), grid_blocks);
}
```

```cpp
#include <hip/hip_runtime.h>
#include <hip/hip_cooperative_groups.h>
#include <cstdio>
#include <cstdint>
namespace cg = cooperative_groups;
namespace pg8 {
#define PG8_LAS __attribute__((address_space(3)))
typedef unsigned short bf16_t;
typedef short bf16x8 __attribute__((ext_vector_type(8)));
typedef float f32x4 __attribute__((ext_vector_type(4)));
typedef unsigned u32x4 __attribute__((ext_vector_type(4)));
constexpr int BM = 256, BK = 64, HALF = 128, HTB = HALF * BK * 2  , STAGE_BYTES = 8 * HTB, NXCD = 8, WGM = 8;

__host__ __device__ __forceinline__ int lds_byte(int r, int c) { const int st = (r >> 4) * 2 + (c >> 5), rr = r & 15, cc = c & 31, ob = rr * 64 + cc * 2; return st * 1024 + (ob ^ (((ob >> 9) & 1) << 5)); }
__host__ __device__ __forceinline__ void stage_rc(int b, int& R, int& C) { const int st = b / 1024, sb = b % 1024, swz = sb ^ (((sb >> 9) & 1) << 5); R = (st >> 1) * 16 + swz / 64; C = (st & 1) * 32 + (swz % 64) / 2; }
__host__ __device__ __forceinline__ int perm32(int rho) { const int n = rho >> 4, i = rho & 15; return 8 * (i >> 2) + 4 * n + (i & 3); }

struct Unit { int pm, pn; };
struct Gemm { const bf16_t* A; const bf16_t* Bt; int M, N, K, lda; };

struct StaticOrder {
    int nM, nN, nwg, G, c;
    __host__ __device__ void init(int M, int N, int G_, int c_) { nM = M / BM; nN = N / BM; nwg = nM * nN; G = G_; c = c_; }
    __host__ __device__ bool next(int i, Unit& u) const {
        const long L = (long)i * G + c; if (L >= nwg) return false;
        int wgid = (int)L; { const int q = nwg / NXCD, r = nwg % NXCD, xcd = wgid % NXCD, off = wgid / NXCD; wgid = (xcd < r ? xcd * (q + 1) : r * (q + 1) + (xcd - r) * q) + off; }
        const int nig = WGM * nN, gid = wgid / nig, fm = gid * WGM, gsz = (nM - fm) < WGM ? (nM - fm) : WGM;
        u.pm = fm + ((wgid % nig) % gsz); u.pn = (wgid % nig) / gsz; return true;
    }
    __device__ __forceinline__ void a_ready(const Unit&) const {}
    __device__ __forceinline__ void done(const Unit&) const {}
};

typedef float f32x2_t __attribute__((ext_vector_type(2))); typedef __bf16 bf16x2_t __attribute__((ext_vector_type(2)));
typedef unsigned u32x2 __attribute__((ext_vector_type(2)));
__device__ __forceinline__ unsigned pk2(float lo, float hi) { f32x2_t v = {lo, hi}; bf16x2_t b = __builtin_convertvector(v, bf16x2_t); return __builtin_bit_cast(unsigned, b); }
__device__ __forceinline__ float row_rstd(const float* ssqp, int row) {
    const f32x4* q = (const f32x4*)(ssqp + (size_t)row * 16); const f32x4 a = q[0], b = q[1], c = q[2], d = q[3];
    const float s = (((a[0] + a[1]) + (a[2] + a[3])) + ((b[0] + b[1]) + (b[2] + b[3]))) + (((c[0] + c[1]) + (c[2] + c[3])) + ((d[0] + d[1]) + (d[2] + d[3])));
    return rsqrtf(s * (1.f / 1024.f) + 1e-6f);
}
__device__ __forceinline__ float act1(float v, int a) {
    if (a == 1) { const float r = v > 0.f ? v : 0.f; return r * r; }
    if (a == 2) { return v * __builtin_amdgcn_rcpf(1.f + __expf(-v)); }
    return v;
}
struct EpiAct {
    static constexpr bool PERM = true, AFTER_DRAIN = false;
    bf16_t* O; const float* bias; const float* ssq; unsigned actmask; int nscale; float scale0;
    const PG8_LAS float* rsl; int pmc;
    template <int ACT> __device__ __forceinline__ void body(const f32x4 (&acc)[2][2][4][2], const Unit& u, int wr, int wc, int fr, int fq) const {
        const int row0 = u.pm * BM + wr * 64 + fr, col0 = u.pn * BM + wc * 32 + 8 * fq;
        const float sc = (u.pn < nscale) ? scale0 : 1.f;
        f32x4 bv[2][2];
#pragma unroll
        for (int bj = 0; bj < 2; ++bj)
#pragma unroll
            for (int n = 0; n < 2; ++n) bv[bj][n] = bias ? *(const f32x4*)(bias + col0 + bj * HALF + 4 * n) : (f32x4){0.f, 0.f, 0.f, 0.f};
#pragma unroll
        for (int ai = 0; ai < 2; ++ai)
#pragma unroll
            for (int m = 0; m < 4; ++m) { const int row = row0 + ai * HALF + m * 16; const float rs = (u.pm == pmc) ? rsl[row & 255] : row_rstd(ssq, row);
                bf16_t* rowp = O + (size_t)row * 4096 + col0;
#pragma unroll
                for (int bj = 0; bj < 2; ++bj) { f32x4 v0 = acc[ai][bj][m][0] * rs + bv[bj][0], v1 = acc[ai][bj][m][1] * rs + bv[bj][1];
                    if (ACT != 0) {
#pragma unroll
                        for (int e = 0; e < 4; ++e) { v0[e] = act1(v0[e], ACT); v1[e] = act1(v1[e], ACT); } }
                    v0 = v0 * sc; v1 = v1 * sc; u32x4 w; w.x = pk2(v0[0], v0[1]); w.y = pk2(v0[2], v0[3]); w.z = pk2(v1[0], v1[1]); w.w = pk2(v1[2], v1[3]);
                    *(u32x4*)(rowp + bj * HALF) = w; } }
    }
    __device__ __forceinline__ void operator()(const f32x4 (&acc)[2][2][4][2], const Unit& u, int wr, int wc, int fr, int fq) const {
        const int act = (int)((actmask >> (2 * u.pn)) & 3u);
        if (act == 1) body<1>(acc, u, wr, wc, fr, fq); else if (act == 2) body<2>(acc, u, wr, wc, fr, fq); else body<0>(acc, u, wr, wc, fr, fq);
    }
};
struct EpiResid {
    static constexpr bool PERM = true, AFTER_DRAIN = false;
    bf16_t* xb; float* ssq;
    __device__ __forceinline__ void operator()(const f32x4 (&acc)[2][2][4][2], const Unit& u, int wr, int wc, int fr, int fq) const {
        const int col0 = u.pn * BM + wc * 32 + 8 * fq;
#pragma unroll
        for (int ai = 0; ai < 2; ++ai) {
            u32x4 bv[4][2];
#pragma unroll
            for (int m = 0; m < 4; ++m) { const size_t off = (size_t)(u.pm * BM + ai * HALF + wr * 64 + m * 16 + fr) * 1024 + col0;
#pragma unroll
                for (int bj = 0; bj < 2; ++bj) bv[m][bj] = *(const u32x4*)(xb + off + bj * HALF); }
#pragma unroll
            for (int m = 0; m < 4; ++m) { const int row = u.pm * BM + ai * HALF + wr * 64 + m * 16 + fr; const size_t off = (size_t)row * 1024 + col0; float s = 0.f;
#pragma unroll
                for (int bj = 0; bj < 2; ++bj) { const u32x4 b = bv[m][bj]; const f32x4 a0 = acc[ai][bj][m][0], a1 = acc[ai][bj][m][1];
                    const float x0 = __uint_as_float(b.x << 16) + a0[0], x1 = __uint_as_float(b.x & 0xffff0000u) + a0[1], x2 = __uint_as_float(b.y << 16) + a0[2], x3 = __uint_as_float(b.y & 0xffff0000u) + a0[3];
                    const float x4 = __uint_as_float(b.z << 16) + a1[0], x5 = __uint_as_float(b.z & 0xffff0000u) + a1[1], x6 = __uint_as_float(b.w << 16) + a1[2], x7 = __uint_as_float(b.w & 0xffff0000u) + a1[3];
                    u32x4 w; w.x = pk2(x0, x1); w.y = pk2(x2, x3); w.z = pk2(x4, x5); w.w = pk2(x6, x7); *(u32x4*)(xb + off + bj * HALF) = w;
                    s += ((x0 * x0 + x1 * x1) + (x2 * x2 + x3 * x3)) + ((x4 * x4 + x5 * x5) + (x6 * x6 + x7 * x7)); }
                s += __shfl_xor(s, 16); s += __shfl_xor(s, 32);
                if (fq == 0) ssq[(size_t)row * 16 + u.pn * 4 + wc] = s; } }
    }
};

template <class Epi, class Sched, int KC, int LDA, bool ALIGN_EPI = false, bool SP2 = false>
__device__ __forceinline__ void gemm_phase(PG8_LAS unsigned char* lds, const Gemm g, const Sched& S, const Epi& E, const int tid) {
    const int wid = __builtin_amdgcn_readfirstlane(tid >> 6), lane = tid & 63, wr = wid >> 2, wc = wid & 3, fr = lane & 15, fq = lane >> 4;
    constexpr int K = KC, nt = KC / BK;
    unsigned voffA[2], voffB[2];
#pragma unroll
    for (int i = 0; i < 2; ++i) { int R, C; stage_rc(tid * 16 + i * 8192, R, C); const int Rb = Epi::PERM ? ((R & ~31) + perm32(R & 31)) : R;
        voffA[i] = (unsigned)(R * LDA + C) * 2u; voffB[i] = (unsigned)(Rb * K + C) * 2u; }
    const size_t kstep = (size_t)(BK * 2);
    const size_t hstepA = (size_t)HALF * LDA * 2, hstepB = (size_t)HALF * K * 2;
    const size_t tstepA = 2 * hstepA, tstepB = 2 * hstepB;
    const unsigned ldsw = (unsigned)wid * 1024u;
    const int aoff = lds_byte(wr * 64 + fr, fq * 8), boff = lds_byte(wc * 32 + fr, fq * 8);
#define PG8_SA(b, h) (((b) * 2 + (h)) * HTB)
#define PG8_SB(b, h) ((4 + (b) * 2 + (h)) * HTB)
#define PG8_STAGE(bufoff, gbase, voff) do { _Pragma("unroll") for (int _i = 0; _i < 2; ++_i) \
        __builtin_amdgcn_global_load_lds((const unsigned*)((const char*)(gbase) + (voff)[_i]), (PG8_LAS unsigned*)(lds + (bufoff) + ldsw + _i * 8192), 16, 0, 0); } while (0)
#define PG8_LDA(dst, b, h) do { _Pragma("unroll") for (int m = 0; m < 4; ++m) _Pragma("unroll") for (int k = 0; k < 2; ++k) dst[m][k] = *(const PG8_LAS bf16x8*)(lds + PG8_SA(b, h) + aoff + m * 2048 + k * 1024); } while (0)
#define PG8_LDB(dst, b, h) do { _Pragma("unroll") for (int n = 0; n < 2; ++n) _Pragma("unroll") for (int k = 0; k < 2; ++k) dst[n][k] = *(const PG8_LAS bf16x8*)(lds + PG8_SB(b, h) + boff + n * 2048 + k * 1024); } while (0)
#define PG8_MMA(ai, bj, At, Bt) do { __builtin_amdgcn_s_setprio(1); _Pragma("unroll") for (int m = 0; m < 4; ++m) _Pragma("unroll") for (int n = 0; n < 2; ++n) _Pragma("unroll") for (int k = 0; k < 2; ++k) \
        acc[ai][bj][m][n] = __builtin_amdgcn_mfma_f32_16x16x32_bf16(Bt[n][k], At[m][k], acc[ai][bj][m][n], 0, 0, 0); __builtin_amdgcn_s_setprio(0); } while (0)
#define PG8_WAIT_V(n) asm volatile("s_waitcnt vmcnt(" #n ")" ::: "memory")
#define PG8_WAIT_L(n) asm volatile("s_waitcnt lgkmcnt(" #n ")" ::: "memory")
#define PG8_BAR __builtin_amdgcn_s_barrier()
#define PG8_SCHED __builtin_amdgcn_sched_barrier(0)
    Unit cur, nxt; int ui = 0;
    if (!S.next(0, cur)) return;
    f32x4 acc[2][2][4][2];
#pragma unroll
    for (int a = 0; a < 2; ++a)
#pragma unroll
        for (int b = 0; b < 2; ++b)
#pragma unroll
            for (int m = 0; m < 4; ++m)
#pragma unroll
                for (int n = 0; n < 2; ++n) acc[a][b][m][n] = (f32x4){0.f, 0.f, 0.f, 0.f};
    bf16x8 At[4][2], B0[2][2], B1[2][2];
    const char* cA = (const char*)g.A + (size_t)cur.pm * tstepA; const char* cB = (const char*)g.Bt + (size_t)cur.pn * tstepB;
    S.a_ready(cur);
    if constexpr (SP2) {
        PG8_STAGE(PG8_SB(0, 0), cB, voffB); PG8_STAGE(PG8_SB(0, 1), cB + hstepB, voffB); PG8_STAGE(PG8_SA(0, 0), cA, voffA); PG8_STAGE(PG8_SA(0, 1), cA + hstepA, voffA);
        if (wr == 1) PG8_BAR;
        PG8_WAIT_V(2); PG8_BAR;
        PG8_STAGE(PG8_SB(1, 0), cB + kstep, voffB); PG8_STAGE(PG8_SA(1, 0), cA + kstep, voffA); PG8_STAGE(PG8_SB(1, 1), cB + hstepB + kstep, voffB);
        PG8_WAIT_V(6); PG8_BAR;
    } else {
        PG8_STAGE(PG8_SB(0, 0), cB, voffB); PG8_STAGE(PG8_SA(0, 0), cA, voffA); PG8_STAGE(PG8_SB(0, 1), cB + hstepB, voffB); PG8_STAGE(PG8_SA(0, 1), cA + hstepA, voffA);
        if (wr == 1) PG8_BAR;
        PG8_WAIT_V(4); PG8_BAR;
        PG8_STAGE(PG8_SB(1, 0), cB + kstep, voffB); PG8_STAGE(PG8_SA(1, 0), cA + kstep, voffA); PG8_STAGE(PG8_SB(1, 1), cB + hstepB + kstep, voffB);
        PG8_WAIT_V(6); PG8_BAR;
    }
    for (;;) {
        const bool has_next = S.next(ui + 1, nxt);
        const char* nA = has_next ? (const char*)g.A + (size_t)nxt.pm * tstepA : cA; const char* nB = has_next ? (const char*)g.Bt + (size_t)nxt.pn * tstepB : cB;
        for (int t = 0; t < nt; t += 2) {
            const bool last = (t == nt - 2);
            const char* a1 = cA + (size_t)(t + 1) * kstep;
            const char* a2 = last ? nA : cA + (size_t)(t + 2) * kstep; const char* b2 = last ? nB : cB + (size_t)(t + 2) * kstep;
            const char* a3 = a2 + kstep; const char* b3 = b2 + kstep;
            if (last && has_next) S.a_ready(nxt);
            if constexpr (SP2) {
            PG8_LDB(B0, 0, 0); PG8_LDB(B1, 0, 1); PG8_SCHED; PG8_LDA(At, 0, 0); PG8_STAGE(PG8_SA(1, 1), a1 + hstepA, voffA);
            PG8_WAIT_V(8); PG8_WAIT_L(0); PG8_BAR; PG8_MMA(0, 0, At, B0); PG8_MMA(0, 1, At, B1); PG8_BAR; PG8_SCHED;
            PG8_LDA(At, 0, 1); PG8_STAGE(PG8_SB(0, 0), b2, voffB); PG8_STAGE(PG8_SB(0, 1), b2 + hstepB, voffB); PG8_STAGE(PG8_SA(0, 0), a2, voffA);
            PG8_WAIT_V(8); PG8_WAIT_L(0); PG8_BAR; PG8_MMA(1, 0, At, B0); PG8_MMA(1, 1, At, B1); PG8_BAR; PG8_SCHED;
            PG8_LDB(B0, 1, 0); PG8_LDB(B1, 1, 1); PG8_SCHED; PG8_LDA(At, 1, 0); PG8_STAGE(PG8_SA(0, 1), a2 + hstepA, voffA);
            PG8_WAIT_V(8); PG8_WAIT_L(0); PG8_BAR; PG8_MMA(0, 0, At, B0); PG8_MMA(0, 1, At, B1); PG8_BAR; PG8_SCHED;
            PG8_LDA(At, 1, 1); PG8_STAGE(PG8_SB(1, 0), b3, voffB); PG8_STAGE(PG8_SB(1, 1), b3 + hstepB, voffB); PG8_STAGE(PG8_SA(1, 0), a3, voffA);
            PG8_WAIT_V(8); PG8_WAIT_L(0); PG8_BAR; PG8_MMA(1, 0, At, B0); PG8_MMA(1, 1, At, B1); PG8_BAR; PG8_SCHED;
            } else {
            PG8_LDB(B0, 0, 0); PG8_SCHED; PG8_LDA(At, 0, 0); PG8_STAGE(PG8_SA(1, 1), a1 + hstepA, voffA);
            PG8_WAIT_L(8); PG8_BAR; PG8_WAIT_L(0); PG8_MMA(0, 0, At, B0); PG8_BAR; PG8_SCHED;
            PG8_LDB(B1, 0, 1); PG8_STAGE(PG8_SB(0, 0), b2, voffB);
            PG8_BAR; PG8_WAIT_L(0); PG8_MMA(0, 1, At, B1); PG8_BAR;
            PG8_LDA(At, 0, 1); PG8_STAGE(PG8_SA(0, 0), a2, voffA);
            PG8_BAR; PG8_WAIT_L(0); PG8_MMA(1, 0, At, B0); PG8_BAR; PG8_SCHED;
            PG8_STAGE(PG8_SB(0, 1), b2 + hstepB, voffB);
            PG8_WAIT_V(6); PG8_BAR; PG8_MMA(1, 1, At, B1); PG8_BAR;
            PG8_LDB(B0, 1, 0); PG8_SCHED; PG8_LDA(At, 1, 0); PG8_STAGE(PG8_SA(0, 1), a2 + hstepA, voffA);
            PG8_WAIT_L(8); PG8_BAR; PG8_WAIT_L(0); PG8_MMA(0, 0, At, B0); PG8_BAR; PG8_SCHED;
            PG8_LDB(B1, 1, 1); PG8_STAGE(PG8_SB(1, 0), b3, voffB);
            PG8_BAR; PG8_WAIT_L(0); PG8_MMA(0, 1, At, B1); PG8_BAR;
            PG8_LDA(At, 1, 1); PG8_STAGE(PG8_SA(1, 0), a3, voffA);
            PG8_BAR; PG8_WAIT_L(0); PG8_MMA(1, 0, At, B0); PG8_BAR; PG8_SCHED;
            PG8_STAGE(PG8_SB(1, 1), b3 + hstepB, voffB);
            PG8_WAIT_V(6); PG8_BAR; PG8_MMA(1, 1, At, B1); PG8_BAR;
            }
        }
        if constexpr (ALIGN_EPI) { if (wr == 0) PG8_BAR; }
        if constexpr (!Epi::AFTER_DRAIN) { E(acc, cur, wr, wc, fr, fq); S.done(cur); }
        if (!has_next) break;
#pragma unroll
        for (int a = 0; a < 2; ++a)
#pragma unroll
            for (int b = 0; b < 2; ++b)
#pragma unroll
                for (int m = 0; m < 4; ++m)
#pragma unroll
                    for (int n = 0; n < 2; ++n) acc[a][b][m][n] = (f32x4){0.f, 0.f, 0.f, 0.f};
        cur = nxt; cA = nA; cB = nB; ++ui;
        if constexpr (ALIGN_EPI) { if (wr == 1) PG8_BAR; }
    }
    PG8_WAIT_V(0);
    if constexpr (!ALIGN_EPI) { if (wr == 0) PG8_BAR; }
    PG8_BAR;
    if constexpr (Epi::AFTER_DRAIN) { E.fused(acc, cur, wr, wc, fr, fq, lds, wid, lane); S.done(cur); }
#undef PG8_SA
#undef PG8_SB
#undef PG8_STAGE
#undef PG8_LDA
#undef PG8_LDB
#undef PG8_MMA
#undef PG8_WAIT_V
#undef PG8_WAIT_L
#undef PG8_BAR
#undef PG8_SCHED
}
}
#define LAS __attribute__((address_space(3)))
typedef unsigned short bf16_t;
typedef short bf16x8 __attribute__((ext_vector_type(8)));
typedef short s16x4 __attribute__((ext_vector_type(4)));
typedef float f32x4 __attribute__((ext_vector_type(4)));
typedef float f32x16 __attribute__((ext_vector_type(16)));
typedef unsigned u32x4 __attribute__((ext_vector_type(4)));
typedef unsigned u32x2 __attribute__((ext_vector_type(2)));
using pg8::pk2; using pg8::row_rstd;
#define MFMA16(a, b, c) __builtin_amdgcn_mfma_f32_16x16x32_bf16((a), (b), (c), 0, 0, 0)
#define MFMA32(a, b, c) __builtin_amdgcn_mfma_f32_32x32x16_bf16((a), (b), (c), 0, 0, 0)

constexpr int T = 16384, D = 1024, FF = 4096, NTHR = 512, NWV = 8;
constexpr float EPS = 1e-6f, LOG2E = 1.4426950408889634f;
constexpr size_t MiB = 1u << 20;
constexpr size_t WS_BIG = 0, WS_XB = 128 * MiB, WS_WMIX = 160 * MiB, WS_WMLP = 172 * MiB, WS_DS = 188 * MiB, WS_MISC = 204 * MiB;
constexpr size_t WS_SSQ = WS_MISC  , WS_LF = WS_MISC + 9 * MiB, WS_C2 = WS_MISC + 10 * MiB, WS_PK = WS_MISC + 11 * MiB, WS_DSEG = WS_MISC + 12 * MiB, WS_SEG = WS_MISC + 13 * MiB  , WS_BAR = WS_MISC + 14 * MiB  , WS_WMIX2 = WS_MISC + 16 * MiB  , WS_END = WS_MISC + 28 * MiB;
constexpr int LDS_CTL = 8 * 17664;
constexpr int LDS_BYTES = 8 * 17664 + 1024;

struct Params { const float* in[17]; float* out; unsigned char* ws; };
typedef const __attribute__((address_space(4))) Params* PP;

__device__ __forceinline__ float bf_lo(unsigned w) { return __uint_as_float(w << 16); }
__device__ __forceinline__ float bf_hi(unsigned w) { return __uint_as_float(w & 0xffff0000u); }
__device__ __forceinline__ float bf_get(const u32x4& v, int i) { const unsigned w = v[i >> 1]; return (i & 1) ? bf_hi(w) : bf_lo(w); }
__device__ __forceinline__ float wave_sum(float v) {
#pragma unroll
    for (int o = 1; o < 64; o <<= 1) v += __shfl_xor(v, o);
    return v;
}
#define LDS_WAIT() asm volatile("s_waitcnt lgkmcnt(0)" ::: "memory")
#define LBAR() do { asm volatile("s_waitcnt lgkmcnt(0)" ::: "memory"); __builtin_amdgcn_s_barrier(); asm volatile("" ::: "memory"); } while (0)

#define RLX_AGENT __ATOMIC_RELAXED, __HIP_MEMORY_SCOPE_AGENT
#define XB_TMO      128
#define XB_XCNT(j)  (256  + 64 * (j))
#define XB_XSUB(j)  (1280 + 64 * (j))
#define XB_XGEN(j)  (2304 + 64 * (j))
#define XB_TOP      3328
#define XB_TOPGEN   3392
#define XCD_BAR_WORDS 3456
#define XB_SPIN_CAP (1u << 18)

__device__ __forceinline__ unsigned xb_ld(unsigned* p)              { return __hip_atomic_load(p, __ATOMIC_RELAXED, __HIP_MEMORY_SCOPE_AGENT); }
__device__ __forceinline__ unsigned xb_add(unsigned* p, unsigned v) { return __hip_atomic_fetch_add(p, v, __ATOMIC_RELAXED, __HIP_MEMORY_SCOPE_AGENT); }
__device__ __forceinline__ unsigned xb_xcc_id() { return (unsigned)__builtin_amdgcn_s_getreg((3 << 11) | 20) & 0xFu; }
#define XB_SPIN(cond, bar) do { unsigned _sp = 0; while (cond) { __builtin_amdgcn_s_sleep(1); \
    if ((++_sp & 255u) == 0u) { if (xb_ld(&(bar)[XB_TMO])) break; if (_sp > XB_SPIN_CAP) { atomicAdd(&(bar)[XB_TMO], 1u); break; } } } } while (0)

struct XcdBarrier {
    unsigned* bar; unsigned x;
    volatile LAS unsigned* st;
};

__device__ __forceinline__ XcdBarrier xcd_barrier_post(unsigned* bar, volatile LAS unsigned* st) {
    XcdBarrier b; b.bar = bar; b.x = xb_xcc_id(); b.st = st;
    if (threadIdx.x == 0) (void)xb_add(&bar[XB_XCNT(b.x)], 1u);
    return b;
}
__device__ __forceinline__ void xcd_barrier_complete(unsigned* bar, unsigned x, unsigned& nloc, unsigned& nx) {
    const unsigned G = gridDim.x * gridDim.y * gridDim.z;
    unsigned sum, cnt, mine, sp = 0u;
    for (;;) {
        sum = 0u; cnt = 0u; mine = 0u;
#pragma unroll
        for (unsigned j = 0; j < 16; ++j) { const unsigned c = xb_ld(&bar[XB_XCNT(j)]); sum += c; cnt += (c > 0u) ? 1u : 0u; mine = (j == x) ? c : mine; }
        if (sum == G) break;
        __builtin_amdgcn_s_sleep(1);
        if ((++sp & 255u) == 0u) { if (xb_ld(&bar[XB_TMO])) break; if (sp > XB_SPIN_CAP) { atomicAdd(&bar[XB_TMO], 1u); break; } }
    }
    nloc = mine > 0u ? mine : 1u; nx = cnt > 0u ? cnt : 1u;
}

__device__ __forceinline__ void xcd_barrier(const XcdBarrier& b) {
    asm volatile("s_waitcnt vmcnt(0)" ::: "memory");
    __syncthreads();
    if (threadIdx.x == 0) {
        unsigned* bar = b.bar;
        __builtin_amdgcn_s_waitcnt(0);
        unsigned nloc = b.st[0], nx = b.st[1];
        if (nloc == 0u) { xcd_barrier_complete(bar, b.x, nloc, nx); b.st[0] = nloc; b.st[1] = nx; }
        const unsigned old = xb_add(&bar[XB_XSUB(b.x)], 1u);
        const unsigned gen = old / nloc;
        if (old + 1u == (gen + 1u) * nloc) {
            __builtin_amdgcn_fence(__ATOMIC_RELEASE, "agent");
            asm volatile("s_waitcnt vmcnt(0)" ::: "memory");
            const unsigned og = xb_add(&bar[XB_TOP], 1u);
            const unsigned tg = og / nx;
            if (og + 1u == (tg + 1u) * nx) xb_add(&bar[XB_TOPGEN], 1u);
            else XB_SPIN(xb_ld(&bar[XB_TOPGEN]) == tg, bar);
            __builtin_amdgcn_fence(__ATOMIC_ACQUIRE, "agent");
            xb_add(&bar[XB_XGEN(b.x)], 1u);
            asm volatile("s_waitcnt vmcnt(0)" ::: "memory");
        } else {
            XB_SPIN(xb_ld(&bar[XB_XGEN(b.x)]) == gen, bar);
            __builtin_amdgcn_fence(__ATOMIC_ACQUIRE, "agent");
            asm volatile("s_waitcnt vmcnt(0)" ::: "memory");
        }
    }
    __syncthreads();
}

constexpr int CONV_SCR_BYTES = 17664;
__device__ __forceinline__ void conv_load(f32x4 (&v)[8], const float* W, int ldw, int kb, int nb, int lane) {
    const int k0 = 64 * kb, n0 = 32 * nb, kr = lane >> 3, nc = (lane & 7) * 4;
#pragma unroll
    for (int i = 0; i < 8; ++i) v[i] = __builtin_nontemporal_load((const f32x4*)(W + (size_t)(k0 + 8 * i + kr) * ldw + n0 + nc));
}
__device__ __forceinline__ void conv_store(const f32x4 (&v)[8], int K, bf16_t* WT, const float* gain, LAS float* scr, int kb, int nb, int lane) {
    const int k0 = 64 * kb, n0 = 32 * nb, kr = lane >> 3, nc = (lane & 7) * 4;
    float g[8];
#pragma unroll
    for (int i = 0; i < 8; ++i) g[i] = gain ? gain[k0 + 8 * i + kr] : 1.f;
#pragma unroll
    for (int i = 0; i < 8; ++i) { const int k = 8 * i + kr; *(LAS f32x4*)(scr + k * 36 + 4 * (k >> 3) + nc) = v[i] * g[i]; }
    LDS_WAIT();
    const int c = lane & 7;
#pragma unroll
    for (int j = 0; j < 4; ++j) { const int n = (lane >> 3) + 8 * j; const LAS float* s = scr + (8 * c) * 36 + 4 * c + n;
        u32x4 o; o.x = pk2(s[0 * 36], s[1 * 36]); o.y = pk2(s[2 * 36], s[3 * 36]); o.z = pk2(s[4 * 36], s[5 * 36]); o.w = pk2(s[6 * 36], s[7 * 36]);
        *(u32x4*)(WT + (size_t)(n0 + n) * K + k0 + 8 * c) = o; }
    LDS_WAIT();
}
__device__ __forceinline__ void convert_w(const float* W, int ldw, int K, int N, bf16_t* WT, const float* gain, LAS float* scr, int gw, int ngw, int lane) {
    const int nblk = N / 32, nitems = (K / 64) * nblk;
    f32x4 v[8], v1[8], v2[8];
#pragma unroll
    for (int i = 0; i < 8; ++i) { v[i] = (f32x4){0.f, 0.f, 0.f, 0.f}; v1[i] = v[i]; v2[i] = v[i]; }
    int it = gw;
    if (it < nitems) conv_load(v, W, ldw, it / nblk, it % nblk, lane);
    if (it + ngw < nitems) conv_load(v1, W, ldw, (it + ngw) / nblk, (it + ngw) % nblk, lane);
    while (it < nitems) { const int n2 = it + 2 * ngw;
        if (n2 < nitems) conv_load(v2, W, ldw, n2 / nblk, n2 % nblk, lane);
        conv_store(v, K, WT, gain, scr, it / nblk, it % nblk, lane);
#pragma unroll
        for (int i = 0; i < 8; ++i) { v[i] = v1[i]; v1[i] = v2[i]; }
        it += ngw; }
}
__device__ __forceinline__ void conv_mix(PP p, int L, LAS float* scr, int gw, int ngw, int lane) {
    bf16_t* wm = (bf16_t*)(p->ws + ((L & 1) ? WS_WMIX2 : WS_WMIX)); const float* gain = p->in[1] + L * 1024; const int m = L % 3, j = L / 3;
    if (m == 0) { convert_w(p->in[6] + (size_t)j * 1024 * 1536, 1536, 1024, 1536, wm, gain, scr, gw, ngw, lane);
                  convert_w(p->in[9] + (size_t)j * 1024 * 1024, 1024, 1024, 1024, wm + 1536 * 1024, nullptr, scr, gw, ngw, lane); }
    else if (m == 1) { convert_w(p->in[10] + (size_t)j * 1024 * 4096, 4096, 1024, 4096, wm, gain, scr, gw, ngw, lane);
                       convert_w(p->in[13] + (size_t)j * 1024 * 1024, 1024, 1024, 1024, wm + 4096 * 1024, nullptr, scr, gw, ngw, lane); }
    else { const float* w = p->in[14] + (size_t)j * 1024 * 3088;
           convert_w(w, 3088, 1024, 3072, wm, gain, scr, gw, ngw, lane);
           convert_w(p->in[16] + (size_t)j * 1024 * 1024, 1024, 1024, 1024, wm + 3072 * 1024, nullptr, scr, gw, ngw, lane);
           bf16_t* wf = wm + 4096 * 1024;
           for (int idx = gw * 64 + lane; idx < 16 * 1024; idx += ngw * 64) { const int h = idx & 15, k = idx >> 4; wf[h * 1024 + k] = (bf16_t)(pk2(w[(size_t)k * 3088 + 3072 + h] * gain[k], 0.f) & 0xffffu); } }
}
__device__ __forceinline__ void conv_mlp(PP p, int L, LAS float* scr, int gw, int ngw, int lane) {
    bf16_t* wl = (bf16_t*)(p->ws + WS_WMLP);
    convert_w(p->in[4] + (size_t)L * 1024 * 4096, 4096, 1024, 4096, wl, p->in[2] + L * 1024, scr, gw, ngw, lane);
    convert_w(p->in[5] + (size_t)L * 4096 * 1024, 1024, 4096, 1024, wl + 4096 * 1024, nullptr, scr, gw, ngw, lane);
}

template <class Epi, int NC, int KC, int LDA> __device__ __forceinline__ void run_gemm(LAS unsigned char* lds, const bf16_t* A, const bf16_t* Bt, const Epi& E, int tid, int bid, int nblk) {
    pg8::Gemm g{A, Bt, T, NC, KC, LDA}; pg8::StaticOrder S; S.init(T, NC, nblk, bid);
    pg8::gemm_phase<Epi, pg8::StaticOrder, KC, LDA, true, true>(lds, g, S, E, tid);
}
typedef short v4i16_t __attribute__((ext_vector_type(4)));
__device__ __forceinline__ s16x4 vtr(const LAS unsigned char* p) { return __builtin_bit_cast(s16x4, __builtin_amdgcn_ds_read_tr16_b64_v4i16((LAS v4i16_t*)p)); }
struct AttnCfg { bf16_t* buf; int ld, koff, voff, ooff, fox; const float* sinks; const float* c2; const float* pk; const float* seg; };
__device__ __forceinline__ void attn_phase(LAS unsigned char* lds, const AttnCfg c, const int tid, const int bid, const int nblk) {
    constexpr bool FOXC = true;
    const int lane = tid & 63, wid = __builtin_amdgcn_readfirstlane(tid >> 6), r32 = lane & 31, hi = lane >> 5;
    LAS unsigned char* Kl = lds; LAS unsigned char* Vl = lds + 9216; LAS float* c2t = (LAS float*)(lds + 18432); LAS int* flags = (LAS int*)(lds + 18688); LAS float* soff = (LAS float*)(lds + 18816); LAS float* smax = soff + 16; LAS float* bnd = soff + 32;
    const int srow = tid >> 3, sch = tid & 7;
    const float NEG = -INFINITY;
    for (int u = bid; u < 1024; u += nblk) {
        const int h = FOXC ? (u & 15) : 4 * (u & 3) + (wid & 3), qb = FOXC ? (u >> 4) : (u >> 2), kvh = FOXC ? h : (u & 3);
        const int tw = FOXC ? qb * 256 + 32 * wid : qb * 64 + 32 * (wid >> 2), qpos = tw + r32;
        const bf16_t* qp = c.buf + (size_t)qpos * c.ld + h * 64 + 8 * hi;
        bf16x8 qr[4];
#pragma unroll
        for (int d0 = 0; d0 < 4; ++d0) qr[d0] = *(const bf16x8*)(qp + 16 * d0);
        if (FOXC) {
            if (wid == 0) { const float v = (lane < 16) ? c.seg[h * 16 + lane] : 0.f, mv = (lane < 16) ? c.seg[256 + h * 16 + lane] : 0.f; float is = v, im = mv;
#pragma unroll
                for (int o = 1; o < 16; o <<= 1) { const float x = __shfl_up(is, o), y = __shfl_up(im, o); if (lane >= o) { is += x; im = fmaxf(im, y); } }
                float em = __shfl_up(im, 1); if (lane == 0) em = 0.f;
                if (lane < 16) { soff[lane] = is - v; smax[lane] = em; } }
            LBAR(); }
        float qn = 0.f, cq = 0.f;
        if (FOXC) { float ss = 0.f;
#pragma unroll
            for (int d0 = 0; d0 < 4; ++d0)
#pragma unroll
                for (int e = 0; e < 8; ++e) { const float v = __uint_as_float(((unsigned)(unsigned short)qr[d0][e]) << 16); ss += v * v; }
            ss += __shfl_xor(ss, 32); qn = sqrtf(ss) * 1.0001f; cq = c.c2[(size_t)h * T + qpos] + soff[qpos >> 10]; }
        float m = FOXC ? -1e30f : c.sinks[h] * LOG2E, l = FOXC ? 0.f : (hi == 0 ? 1.f : 0.f);
        f32x16 o0, o1;
#pragma unroll
        for (int i = 0; i < 16; ++i) { o0[i] = 0.f; o1[i] = 0.f; }
        const int kt_hi = FOXC ? 4 * qb + 3 : qb, kt_lo = FOXC ? 0 : (qb - 2 > 0 ? qb - 2 : 0);
        const bf16_t* kg = c.buf + c.koff + kvh * 64 + sch * 8; const bf16_t* vg = c.buf + c.voff + kvh * 64 + sch * 8;
        u32x4 kst, vst, kst1 = {0u, 0u, 0u, 0u}, vst1 = {0u, 0u, 0u, 0u}; float cst = 0.f, cst1 = 0.f, pst1 = 0.f;
        { const size_t r = (size_t)(64 * kt_hi + srow) * c.ld; kst = *(const u32x4*)(kg + r); vst = *(const u32x4*)(vg + r); if (FOXC && tid < 64) cst = c.c2[(size_t)h * T + 64 * kt_hi + tid]; }
        if (kt_hi > kt_lo) { const size_t r = (size_t)(64 * (kt_hi - 1) + srow) * c.ld; kst1 = *(const u32x4*)(kg + r); vst1 = *(const u32x4*)(vg + r);
            if (FOXC && tid < 64) { cst1 = c.c2[(size_t)h * T + 64 * (kt_hi - 1) + tid]; if (tid == 63) pst1 = c.pk[(size_t)h * T + 64 * (kt_hi - 1) + 63]; } }
        bool active = true; int par = 0;
        for (int kt = kt_hi;; --kt) {
            *(LAS u32x4*)(Kl + srow * 144 + sch * 16) = kst;
            *(LAS u32x4*)(Vl + srow * 144 + sch * 16) = vst;
            if (FOXC && tid < 64) { c2t[tid] = cst; if (tid == 63) { bnd[0] = cst1; bnd[1] = pst1; } }
            LBAR();
            kst = kst1; vst = vst1; cst = cst1;
            float pkn = 0.f, c2n = 0.f;
            if (FOXC && kt > 0) { const int sp = 64 * kt - 1; pkn = fmaxf(bnd[1], smax[sp >> 10]); c2n = bnd[0] + soff[sp >> 10]; }
            if (kt - 2 >= kt_lo) { const size_t r = (size_t)(64 * (kt - 2) + srow) * c.ld; kst1 = *(const u32x4*)(kg + r); vst1 = *(const u32x4*)(vg + r);
                if (FOXC && tid < 64) { cst1 = c.c2[(size_t)h * T + 64 * (kt - 2) + tid]; if (tid == 63) pst1 = c.pk[(size_t)h * T + 64 * (kt - 2) + 63]; } }
            const bool causal_skip = 64 * kt > tw + 31;
            bool rel = active && !causal_skip; if (!FOXC) rel = rel && (64 * kt + 63 >= tw - 127);
            if (rel) {
                f32x16 p0, p1;
#pragma unroll
                for (int i = 0; i < 16; ++i) { p0[i] = 0.f; p1[i] = 0.f; }
#pragma unroll
                for (int d0 = 0; d0 < 4; ++d0) { const bf16x8 a0 = *(const LAS bf16x8*)(Kl + r32 * 144 + d0 * 32 + hi * 16), a1 = *(const LAS bf16x8*)(Kl + (32 + r32) * 144 + d0 * 32 + hi * 16);
                    p0 = MFMA32(a0, qr[d0], p0); p1 = MFMA32(a1, qr[d0], p1); }
                const bool full = (64 * kt + 63 <= tw) && (FOXC || (tw + 31 - 64 * kt < 128));
                const float cqt = FOXC ? cq - soff[kt >> 4] : 0.f;
                float rm = NEG;
                f32x4 cA[4], cB[4];
                if (FOXC) {
#pragma unroll
                    for (int g = 0; g < 4; ++g) { cA[g] = *(const LAS f32x4*)(c2t + 8 * g + 4 * hi); cB[g] = *(const LAS f32x4*)(c2t + 32 + 8 * g + 4 * hi); } }
#pragma unroll
                for (int i = 0; i < 16; ++i) { const int kvl = (i & 3) + 8 * (i >> 2) + 4 * hi; float s0 = p0[i], s1 = p1[i];
                    if (FOXC) { s0 += cqt - cA[i >> 2][i & 3]; s1 += cqt - cB[i >> 2][i & 3]; }
                    if (!full) { const int kv0 = 64 * kt + kvl, kv1 = kv0 + 32; bool v0 = kv0 <= qpos, v1 = kv1 <= qpos;
                        if (!FOXC) { v0 = v0 && (qpos - kv0 < 128); v1 = v1 && (qpos - kv1 < 128); }
                        s0 = v0 ? s0 : NEG; s1 = v1 ? s1 : NEG; }
                    p0[i] = s0; p1[i] = s1; rm = fmaxf(rm, fmaxf(s0, s1)); }
                rm = fmaxf(rm, __shfl_xor(rm, 32));
                float mn = m; if (__any((rm > m + 8.f) ? 1 : 0)) mn = fmaxf(m, rm);
                const float alpha = __builtin_amdgcn_exp2f(m - mn); m = mn;
                float ls = 0.f;
#pragma unroll
                for (int i = 0; i < 16; ++i) { p0[i] = __builtin_amdgcn_exp2f(p0[i] - mn); p1[i] = __builtin_amdgcn_exp2f(p1[i] - mn); ls += p0[i] + p1[i]; }
                l = l * alpha + ls;
                if (__any(alpha != 1.f ? 1 : 0)) {
#pragma unroll
                    for (int i = 0; i < 16; ++i) { o0[i] *= alpha; o1[i] *= alpha; } }
#pragma unroll
                for (int sp = 0; sp < 4; ++sp) { const int blk = sp >> 1, s = sp & 1; u32x4 pw;
                    if (blk == 0) { pw.x = pk2(p0[8 * s], p0[8 * s + 1]); pw.y = pk2(p0[8 * s + 2], p0[8 * s + 3]); pw.z = pk2(p0[8 * s + 4], p0[8 * s + 5]); pw.w = pk2(p0[8 * s + 6], p0[8 * s + 7]); }
                    else { pw.x = pk2(p1[8 * s], p1[8 * s + 1]); pw.y = pk2(p1[8 * s + 2], p1[8 * s + 3]); pw.z = pk2(p1[8 * s + 4], p1[8 * s + 5]); pw.w = pk2(p1[8 * s + 6], p1[8 * s + 7]); }
                    const bf16x8 pf = __builtin_bit_cast(bf16x8, pw);
                    { const LAS unsigned char* vp = Vl + (32 * blk + 16 * s + 4 * hi + ((lane & 15) >> 2)) * 144 + (16 * ((lane >> 4) & 1) + 4 * (lane & 3)) * 2;
                      const bf16x8 vf0 = __builtin_shufflevector(vtr(vp), vtr(vp + 8 * 144), 0, 1, 2, 3, 4, 5, 6, 7); o0 = MFMA32(vf0, pf, o0);
                      const bf16x8 vf1 = __builtin_shufflevector(vtr(vp + 64), vtr(vp + 64 + 8 * 144), 0, 1, 2, 3, 4, 5, 6, 7); o1 = MFMA32(vf1, pf, o1); } }
            }
            bool need;
            if (FOXC) { need = causal_skip ? true : (active && kt > 0 && __any((qn * pkn + cq - c2n - m > -40.f) ? 1 : 0) != 0); if (!causal_skip) active = need; }
            else need = (64 * kt - 1 >= tw - 127);
            if (lane == 0) flags[par * 8 + wid] = need ? 1 : 0;
            LBAR();
            if (kt == kt_lo) break;
            int any = 0;
#pragma unroll
            for (int w = 0; w < 8; ++w) any |= flags[par * 8 + w];
            par ^= 1;
            if (!any) break;
        }
        const float lt = l + __shfl_xor(l, 32), inv = 1.f / lt;
        bf16_t* ob = c.buf + (size_t)qpos * c.ld + c.ooff + h * 64;
#pragma unroll
        for (int gp = 0; gp < 4; gp += 2) {
            u32x2 a0, b0, a1, b1;
            a0.x = pk2(o0[4 * gp] * inv, o0[4 * gp + 1] * inv); a0.y = pk2(o0[4 * gp + 2] * inv, o0[4 * gp + 3] * inv);
            b0.x = pk2(o0[4 * gp + 4] * inv, o0[4 * gp + 5] * inv); b0.y = pk2(o0[4 * gp + 6] * inv, o0[4 * gp + 7] * inv);
            a1.x = pk2(o1[4 * gp] * inv, o1[4 * gp + 1] * inv); a1.y = pk2(o1[4 * gp + 2] * inv, o1[4 * gp + 3] * inv);
            b1.x = pk2(o1[4 * gp + 4] * inv, o1[4 * gp + 5] * inv); b1.y = pk2(o1[4 * gp + 6] * inv, o1[4 * gp + 7] * inv);
            { auto r = __builtin_amdgcn_permlane32_swap(a0.x, b0.x, false, false); a0.x = r[0]; b0.x = r[1]; }
            { auto r = __builtin_amdgcn_permlane32_swap(a0.y, b0.y, false, false); a0.y = r[0]; b0.y = r[1]; }
            { auto r = __builtin_amdgcn_permlane32_swap(a1.x, b1.x, false, false); a1.x = r[0]; b1.x = r[1]; }
            { auto r = __builtin_amdgcn_permlane32_swap(a1.y, b1.y, false, false); a1.y = r[0]; b1.y = r[1]; }
            u32x4 s0; s0.x = a0.x; s0.y = a0.y; s0.z = b0.x; s0.w = b0.y; u32x4 s1; s1.x = a1.x; s1.y = a1.y; s1.z = b1.x; s1.w = b1.y;
            *(u32x4*)(ob + 8 * gp + 8 * hi) = s0; *(u32x4*)(ob + 32 + 8 * gp + 8 * hi) = s1; }
    }
}

__device__ __forceinline__ void swa_unit(int u, int nblk, int& kvh, int& qb) {
    if (nblk == 256) { const int it = u >> 8, b = u & 255, x = b & 7, j = it * 32 + (b >> 3); qb = 32 * x + (j >> 2); kvh = j & 3; }
    else { kvh = u & 3; qb = u >> 2; }
}
__device__ __forceinline__ void swa_phase(LAS unsigned char* lds, bf16_t* buf, const float* sinks, const int tid, const int bid, const int nblk) {
    const int lane = tid & 63, wid = __builtin_amdgcn_readfirstlane(tid >> 6), r32 = lane & 31, hi = lane >> 5;
    const int srow = tid >> 3, sch = tid & 7; const float NEG = -INFINITY;
    constexpr int LD = 4096, KOFF = 1024, VOFF = 1280, OOFF = 2048;
    u32x4 kp[3], vp[3];
#pragma unroll
    for (int j = 0; j < 3; ++j) { kp[j] = (u32x4){0u, 0u, 0u, 0u}; vp[j] = kp[j]; }
    bf16x8 qnx[4];
#pragma unroll
    for (int d0 = 0; d0 < 4; ++d0) qnx[d0] = (bf16x8){0, 0, 0, 0, 0, 0, 0, 0};
    if (bid < 1024) { int kvh, qb; swa_unit(bid, nblk, kvh, qb);
      { const bf16_t* qp0 = buf + (size_t)(64 * qb + 32 * (wid >> 2) + r32) * LD + (4 * kvh + (wid & 3)) * 64 + 8 * hi;
#pragma unroll
        for (int d0 = 0; d0 < 4; ++d0) qnx[d0] = *(const bf16x8*)(qp0 + 16 * d0); }
#pragma unroll
        for (int j = 0; j < 3; ++j) { const int kt = qb - 2 + j; if (kt >= 0) { const bf16_t* r = buf + (size_t)(64 * kt + srow) * LD + kvh * 64 + sch * 8; kp[j] = *(const u32x4*)(r + KOFF); vp[j] = *(const u32x4*)(r + VOFF); } } }
    for (int u = bid; u < 1024; u += nblk) {
        int kvh, qb; swa_unit(u, nblk, kvh, qb);
        const int h = 4 * kvh + (wid & 3), tw = 64 * qb + 32 * (wid >> 2), qpos = tw + r32;
#pragma unroll
        for (int j = 0; j < 3; ++j) { *(LAS u32x4*)(lds + j * 9216 + srow * 144 + sch * 16) = kp[j]; *(LAS u32x4*)(lds + 27648 + j * 9216 + srow * 144 + sch * 16) = vp[j]; }
        LBAR();
        { const int un = u + nblk; if (un < 1024) { int kvn, qn_; swa_unit(un, nblk, kvn, qn_);
#pragma unroll
            for (int j = 0; j < 3; ++j) { const int kt = qn_ - 2 + j; if (kt >= 0) { const bf16_t* r = buf + (size_t)(64 * kt + srow) * LD + kvn * 64 + sch * 8; kp[j] = *(const u32x4*)(r + KOFF); vp[j] = *(const u32x4*)(r + VOFF); } } } }
        bf16x8 qr[4];
#pragma unroll
        for (int d0 = 0; d0 < 4; ++d0) qr[d0] = qnx[d0];
        { const int un = u + nblk; if (un < 1024) { int kvq, qbq; swa_unit(un, nblk, kvq, qbq); const bf16_t* qpn = buf + (size_t)(64 * qbq + 32 * (wid >> 2) + r32) * LD + (4 * kvq + (wid & 3)) * 64 + 8 * hi;
#pragma unroll
            for (int d0 = 0; d0 < 4; ++d0) qnx[d0] = *(const bf16x8*)(qpn + 16 * d0); } }
        float m = sinks[h] * LOG2E, l = (hi == 0) ? 1.f : 0.f;
        f32x16 o0, o1;
#pragma unroll
        for (int i = 0; i < 16; ++i) { o0[i] = 0.f; o1[i] = 0.f; }
#pragma unroll
        for (int j = 2; j >= 0; --j) { const int kt = qb - 2 + j;
            if (kt >= 0 && 64 * kt + 63 >= tw - 127) {
                const LAS unsigned char* Kl = lds + j * 9216; const LAS unsigned char* Vl = lds + 27648 + j * 9216;
                f32x16 p0, p1;
#pragma unroll
                for (int i = 0; i < 16; ++i) { p0[i] = 0.f; p1[i] = 0.f; }
#pragma unroll
                for (int d0 = 0; d0 < 4; ++d0) { const bf16x8 a0 = *(const LAS bf16x8*)(Kl + r32 * 144 + d0 * 32 + hi * 16), a1 = *(const LAS bf16x8*)(Kl + (32 + r32) * 144 + d0 * 32 + hi * 16);
                    p0 = MFMA32(a0, qr[d0], p0); p1 = MFMA32(a1, qr[d0], p1); }
                const bool full = (64 * kt + 63 <= tw) && (tw + 31 - 64 * kt < 128);
                float rm = NEG;
                if (!full) {
                    const int dq = qpos - 64 * kt - 4 * hi;
#pragma unroll
                    for (int i = 0; i < 16; ++i) { const unsigned d0 = (unsigned)(dq - ((i & 3) + 8 * (i >> 2))), d1 = d0 - 32u;
                        p0[i] = (d0 < 128u) ? p0[i] : NEG; p1[i] = (d1 < 128u) ? p1[i] : NEG; } }
#pragma unroll
                for (int i = 0; i < 16; ++i) rm = fmaxf(rm, fmaxf(p0[i], p1[i]));
                rm = fmaxf(rm, __shfl_xor(rm, 32));
                float mn = m; if (__any((rm > m + 8.f) ? 1 : 0)) mn = fmaxf(m, rm);
                const float alpha = __builtin_amdgcn_exp2f(m - mn); m = mn;
                float ls = 0.f;
#pragma unroll
                for (int i = 0; i < 16; ++i) { p0[i] = __builtin_amdgcn_exp2f(p0[i] - mn); p1[i] = __builtin_amdgcn_exp2f(p1[i] - mn); ls += p0[i] + p1[i]; }
                l = l * alpha + ls;
                if (__any(alpha != 1.f ? 1 : 0)) {
#pragma unroll
                    for (int i = 0; i < 16; ++i) { o0[i] *= alpha; o1[i] *= alpha; } }
#pragma unroll
                for (int sp = 0; sp < 4; ++sp) { const int blk = sp >> 1, s = sp & 1; u32x4 pw;
                    if (blk == 0) { pw.x = pk2(p0[8 * s], p0[8 * s + 1]); pw.y = pk2(p0[8 * s + 2], p0[8 * s + 3]); pw.z = pk2(p0[8 * s + 4], p0[8 * s + 5]); pw.w = pk2(p0[8 * s + 6], p0[8 * s + 7]); }
                    else { pw.x = pk2(p1[8 * s], p1[8 * s + 1]); pw.y = pk2(p1[8 * s + 2], p1[8 * s + 3]); pw.z = pk2(p1[8 * s + 4], p1[8 * s + 5]); pw.w = pk2(p1[8 * s + 6], p1[8 * s + 7]); }
                    const bf16x8 pf = __builtin_bit_cast(bf16x8, pw);
                    const LAS unsigned char* vq = Vl + (32 * blk + 16 * s + 4 * hi + ((lane & 15) >> 2)) * 144 + (16 * ((lane >> 4) & 1) + 4 * (lane & 3)) * 2;
                    const bf16x8 vf0 = __builtin_shufflevector(vtr(vq), vtr(vq + 8 * 144), 0, 1, 2, 3, 4, 5, 6, 7); o0 = MFMA32(vf0, pf, o0);
                    const bf16x8 vf1 = __builtin_shufflevector(vtr(vq + 64), vtr(vq + 64 + 8 * 144), 0, 1, 2, 3, 4, 5, 6, 7); o1 = MFMA32(vf1, pf, o1); }
            } }
        const float lt = l + __shfl_xor(l, 32), inv = 1.f / lt;
        bf16_t* ob = buf + (size_t)qpos * LD + OOFF + h * 64;
#pragma unroll
        for (int gp = 0; gp < 4; gp += 2) {
            u32x2 a0, b0, a1, b1;
            a0.x = pk2(o0[4 * gp] * inv, o0[4 * gp + 1] * inv); a0.y = pk2(o0[4 * gp + 2] * inv, o0[4 * gp + 3] * inv);
            b0.x = pk2(o0[4 * gp + 4] * inv, o0[4 * gp + 5] * inv); b0.y = pk2(o0[4 * gp + 6] * inv, o0[4 * gp + 7] * inv);
            a1.x = pk2(o1[4 * gp] * inv, o1[4 * gp + 1] * inv); a1.y = pk2(o1[4 * gp + 2] * inv, o1[4 * gp + 3] * inv);
            b1.x = pk2(o1[4 * gp + 4] * inv, o1[4 * gp + 5] * inv); b1.y = pk2(o1[4 * gp + 6] * inv, o1[4 * gp + 7] * inv);
            { auto r = __builtin_amdgcn_permlane32_swap(a0.x, b0.x, false, false); a0.x = r[0]; b0.x = r[1]; }
            { auto r = __builtin_amdgcn_permlane32_swap(a0.y, b0.y, false, false); a0.y = r[0]; b0.y = r[1]; }
            { auto r = __builtin_amdgcn_permlane32_swap(a1.x, b1.x, false, false); a1.x = r[0]; b1.x = r[1]; }
            { auto r = __builtin_amdgcn_permlane32_swap(a1.y, b1.y, false, false); a1.y = r[0]; b1.y = r[1]; }
            u32x4 s0; s0.x = a0.x; s0.y = a0.y; s0.z = b0.x; s0.w = b0.y; u32x4 s1; s1.x = a1.x; s1.y = a1.y; s1.z = b1.x; s1.w = b1.y;
            *(u32x4*)(ob + 8 * gp + 8 * hi) = s0; *(u32x4*)(ob + 32 + 8 * gp + 8 * hi) = s1; }
        LBAR();
    }
}

__device__ __forceinline__ void fox_flog(PP p, const float* ssq, const float* bias, int gw, int ngw, int lane) {
    const bf16_t* XB = (const bf16_t*)(p->ws + WS_XB); const bf16_t* WF = (const bf16_t*)(p->ws + WS_WMIX) + 4096 * 1024; float* LF = (float*)(p->ws + WS_LF);
    const int fr = lane & 15, q = lane >> 4;
    for (int tl = gw; tl < T / 16; tl += ngw) { const int t0 = 16 * tl; f32x4 acc = {0.f, 0.f, 0.f, 0.f};
        const bf16_t* ap = XB + (size_t)(t0 + fr) * 1024 + 8 * q; const bf16_t* bp = WF + (size_t)fr * 1024 + 8 * q;
#pragma unroll 8
        for (int ks = 0; ks < 32; ++ks) acc = MFMA16(*(const bf16x8*)(ap + 32 * ks), *(const bf16x8*)(bp + 32 * ks), acc);
        const float bb = bias[fr];
#pragma unroll
        for (int j = 0; j < 4; ++j) { const int t = t0 + 4 * q + j; const float rs = row_rstd(ssq, t); const float v = acc[j] * rs + bb;
            const float ls = (v < 0.f) ? (v - log1pf(__expf(v))) : -log1pf(__expf(-v)); LF[(size_t)t * 16 + fr] = ls * LOG2E; } }
}
__device__ __forceinline__ void fox_scan(LAS unsigned char* lds, PP p, const int tid, const int bid, const int nblk) {
    const int lane = tid & 63, wid = tid >> 6;
    const float* LF = (const float*)(p->ws + WS_LF); float* C2 = (float*)(p->ws + WS_C2); float* PK = (float*)(p->ws + WS_PK); float* SEG = (float*)(p->ws + WS_SEG);
    LAS float* ws_sum = (LAS float*)lds; LAS float* ws_max = ws_sum + 8;
    for (int u = bid; u < 256; u += nblk) { const int h = u & 15, sg = u >> 4, t0 = sg * 1024 + 2 * tid;
        const bf16_t* KB = (const bf16_t*)(p->ws + WS_BIG) + 1024 + h * 64 + (size_t)t0 * 4096;
        u32x4 ka[8], kb[8];
#pragma unroll
        for (int c = 0; c < 8; ++c) { ka[c] = *(const u32x4*)(KB + 8 * c); kb[c] = *(const u32x4*)(KB + 4096 + 8 * c); }
        const float l0 = LF[(size_t)t0 * 16 + h], l1 = LF[(size_t)(t0 + 1) * 16 + h];
        float n0 = 0.f, n1 = 0.f;
#pragma unroll
        for (int c = 0; c < 8; ++c)
#pragma unroll
            for (int e = 0; e < 8; ++e) { const float f0 = bf_get(ka[c], e), f1 = bf_get(kb[c], e); n0 += f0 * f0; n1 += f1 * f1; }
        const float s = l0 + l1, mx = fmaxf(n0, n1);
        float is = s, im = mx;
#pragma unroll
        for (int o = 1; o < 64; o <<= 1) { const float a = __shfl_up(is, o), b = __shfl_up(im, o); if (lane >= o) { is += a; im = fmaxf(im, b); } }
        if (lane == 63) { ws_sum[wid] = is; ws_max[wid] = im; }
        __syncthreads();
        float es = is - s, em = __shfl_up(im, 1); if (lane == 0) em = 0.f;
        for (int w = 0; w < wid; ++w) { es += ws_sum[w]; em = fmaxf(em, ws_max[w]); }
        const float m0 = fmaxf(em, n0), m1 = fmaxf(m0, n1);
        C2[(size_t)h * T + t0] = es + l0; C2[(size_t)h * T + t0 + 1] = (es + l0) + l1;
        PK[(size_t)h * T + t0] = sqrtf(m0) * 1.0001f; PK[(size_t)h * T + t0 + 1] = sqrtf(m1) * 1.0001f;
        if (tid == NTHR - 1) { SEG[h * 16 + sg] = (es + l0) + l1; SEG[256 + h * 16 + sg] = sqrtf(m1) * 1.0001f; }
        __syncthreads();
    }
}
__device__ __forceinline__ void hgrn_x1(LAS unsigned char* lds, PP p, int layer, const int tid, const int bid, const int nblk) {
    bf16_t* PB = (bf16_t*)(p->ws + WS_BIG); float* DS = (float*)(p->ws + WS_DS); float* DSEG = (float*)(p->ws + WS_DSEG); const float* lbl = p->in[11];
    LAS float* LF = (LAS float*)lds;
    LAS float* GT = (LAS float*)(lds + 16896);
    LAS float* BP = (LAS float*)(lds + 18944);
    LAS float* ED = (LAS float*)(lds + 19456);
    LAS float* LB = (LAS float*)(lds + 19968);
    LAS unsigned char* QT = lds + 20480;
    LAS unsigned char* KT = lds + 29184;
    LAS unsigned char* KH = lds + 37888;
    LAS unsigned char* VT = lds + 46592;
    const int lane = tid & 63, wid = __builtin_amdgcn_readfirstlane(tid >> 6), fr = lane & 15, q = lane >> 4;
    const int pt = tid >> 4, kg = tid & 15, ck = tid & 127, ctg = tid >> 7;
    for (int u = bid; u < 256; u += nblk) {
        const int h = u >> 5, sg = u & 31, row0 = sg * 512;
        if (tid < 128) { const int kk = h * 128 + tid; const float a0 = lbl[kk], a1 = lbl[1024 + kk], a2 = lbl[2048 + kk], a3 = lbl[3072 + kk];
            const float mx = fmaxf(fmaxf(a0, a1), fmaxf(a2, a3)); const float e0 = __expf(a0 - mx), e1 = __expf(a1 - mx), e2 = __expf(a2 - mx), e3 = __expf(a3 - mx);
            float lbv = 0.f; if (layer >= 1) lbv += e1; if (layer >= 2) lbv += e2; if (layer >= 3) lbv += e3;
            LB[tid] = lbv / (e0 + e1 + e2 + e3); BP[tid] = 0.f; }
        f32x4 S[8];
#pragma unroll
        for (int i = 0; i < 8; ++i) S[i] = (f32x4){0.f, 0.f, 0.f, 0.f};
        u32x4 nq, nz, nv;
        { const bf16_t* nb = PB + (size_t)(row0 + pt) * 4096 + h * 128 + 8 * kg; nq = *(const u32x4*)nb; nz = *(const u32x4*)(nb + 1024); nv = *(const u32x4*)(nb + 2048); }
        __syncthreads();
        for (int c = 0; c < 16; ++c) {
            const int crow0 = row0 + 32 * c;
            bf16_t* base = PB + (size_t)(crow0 + pt) * 4096 + h * 128 + 8 * kg;
            const u32x4 qv = nq, zv = nz, vv = nv;
            if (c + 1 < 16) { const bf16_t* nb = base + (size_t)32 * 4096; nq = *(const u32x4*)nb; nz = *(const u32x4*)(nb + 1024); nv = *(const u32x4*)(nb + 2048); }
            float fk[8], qs[8], blast[8];
            const f32x4 lbA = *(const LAS f32x4*)(LB + 8 * kg), lbB = *(const LAS f32x4*)(LB + 8 * kg + 4);
#pragma unroll
            for (int i = 0; i < 8; ++i) { const float z = bf_get(zv, i), lb = (i < 4) ? lbA[i & 3] : lbB[i & 3]; const float sgm = 1.f / (1.f + __expf(-z)); const float f = lb + (1.f - lb) * sgm;
                LF[pt * 132 + 8 * kg + i] = __logf(f); fk[i] = 1.f - f; qs[i] = bf_get(qv, i); }
            LBAR();
            { float run = 0.f;
#pragma unroll
              for (int tt = 0; tt < 8; ++tt) { const int a = (8 * ctg + tt) * 132 + ck; run += LF[a]; LF[a] = run; }
              GT[ctg * 128 + ck] = run; }
            LBAR();
            { const int tgp = pt >> 3; float qt[8], ktv[8], qg[8], khv[8];
              f32x4 gA[4], gB[4];
#pragma unroll
              for (int g = 0; g < 4; ++g) { gA[g] = *(const LAS f32x4*)(GT + g * 128 + 8 * kg); gB[g] = *(const LAS f32x4*)(GT + g * 128 + 8 * kg + 4); }
              const f32x4 lfA = *(const LAS f32x4*)(LF + pt * 132 + 8 * kg), lfB = *(const LAS f32x4*)(LF + pt * 132 + 8 * kg + 4);
              const f32x4 bpA = *(const LAS f32x4*)(BP + 8 * kg), bpB = *(const LAS f32x4*)(BP + 8 * kg + 4);
#pragma unroll
              for (int i = 0; i < 8; ++i) { const int k = 8 * kg + i; const int e = i & 3;
                  const float g0 = (i < 4) ? gA[0][e] : gB[0][e], g1 = (i < 4) ? gA[1][e] : gB[1][e], g2 = (i < 4) ? gA[2][e] : gB[2][e], g3 = (i < 4) ? gA[3][e] : gB[3][e];
                  const float pre = (tgp > 0 ? g0 : 0.f) + (tgp > 1 ? g1 : 0.f) + (tgp > 2 ? g2 : 0.f); const float bl = (g0 + g1) + (g2 + g3);
                  const float b = ((i < 4) ? lfA[e] : lfB[e]) + pre; const float Bp = (i < 4) ? bpA[e] : bpB[e];
                  qt[i] = qs[i] * __expf(b); ktv[i] = fk[i] * __expf(fminf(-b, 80.f)); khv[i] = fk[i] * __expf(bl - b); qg[i] = qs[i] * __expf(Bp + b);
                  blast[i] = bl; if (pt == 31) ED[k] = __expf(bl); }
              u32x4 w; w.x = pk2(qt[0], qt[1]); w.y = pk2(qt[2], qt[3]); w.z = pk2(qt[4], qt[5]); w.w = pk2(qt[6], qt[7]); *(LAS u32x4*)(QT + pt * 272 + kg * 16) = w;
              w.x = pk2(ktv[0], ktv[1]); w.y = pk2(ktv[2], ktv[3]); w.z = pk2(ktv[4], ktv[5]); w.w = pk2(ktv[6], ktv[7]); *(LAS u32x4*)(KT + pt * 272 + kg * 16) = w;
              w.x = pk2(khv[0], khv[1]); w.y = pk2(khv[2], khv[3]); w.z = pk2(khv[4], khv[5]); w.w = pk2(khv[6], khv[7]); *(LAS u32x4*)(KH + pt * 272 + kg * 16) = w;
              *(LAS u32x4*)(VT + pt * 272 + kg * 16) = vv;
              w.x = pk2(qg[0], qg[1]); w.y = pk2(qg[2], qg[3]); w.z = pk2(qg[4], qg[5]); w.w = pk2(qg[6], qg[7]); *(u32x4*)base = w; }
            LBAR();
            if (pt == 31) {
#pragma unroll
                for (int i = 0; i < 8; ++i) BP[8 * kg + i] += blast[i]; }
            { f32x4 AT00 = {0.f, 0.f, 0.f, 0.f}, AT01 = AT00, AT11 = AT00;
#pragma unroll
              for (int ks = 0; ks < 4; ++ks) { const bf16x8 a0 = *(const LAS bf16x8*)(KT + fr * 272 + ks * 64 + q * 16), a1 = *(const LAS bf16x8*)(KT + (16 + fr) * 272 + ks * 64 + q * 16);
                  const bf16x8 b0 = *(const LAS bf16x8*)(QT + fr * 272 + ks * 64 + q * 16), b1 = *(const LAS bf16x8*)(QT + (16 + fr) * 272 + ks * 64 + q * 16);
                  AT00 = MFMA16(a0, b0, AT00); AT01 = MFMA16(a0, b1, AT01); AT11 = MFMA16(a1, b1, AT11); }
#pragma unroll
              for (int j = 0; j < 4; ++j) if (4 * q + j > fr) { AT00[j] = 0.f; AT11[j] = 0.f; }
              u32x4 w0, w1; w0.x = pk2(AT00[0], AT00[1]); w0.y = pk2(AT00[2], AT00[3]); w0.z = 0u; w0.w = 0u;
              w1.x = pk2(AT01[0], AT01[1]); w1.y = pk2(AT01[2], AT01[3]); w1.z = pk2(AT11[0], AT11[1]); w1.w = pk2(AT11[2], AT11[3]);
              const bf16x8 Bp0 = __builtin_bit_cast(bf16x8, w0), Bp1 = __builtin_bit_cast(bf16x8, w1);
              const LAS unsigned char* vcol = VT + (fr >> 2) * 272 + (16 * wid + 4 * (fr & 3)) * 2;
              const bf16x8 va = __builtin_shufflevector(vtr(vcol + (4 * q) * 272), vtr(vcol + (16 + 4 * q) * 272), 0, 1, 2, 3, 4, 5, 6, 7);
              const f32x4 zero4 = {0.f, 0.f, 0.f, 0.f};
              f32x4 oT0 = MFMA16(va, Bp0, zero4), oT1 = MFMA16(va, Bp1, zero4);
#pragma unroll
              for (int kk = 0; kk < 4; ++kk) { u32x4 sw; sw.x = pk2(S[2 * kk][0], S[2 * kk][1]); sw.y = pk2(S[2 * kk][2], S[2 * kk][3]); sw.z = pk2(S[2 * kk + 1][0], S[2 * kk + 1][1]); sw.w = pk2(S[2 * kk + 1][2], S[2 * kk + 1][3]);
                  const bf16x8 sa = __builtin_bit_cast(bf16x8, sw);
                  const LAS unsigned char* q0p = QT + fr * 272 + kk * 64 + q * 8; const LAS unsigned char* q1p = q0p + 16 * 272;
                  const bf16x8 qb0 = __builtin_shufflevector(*(const LAS s16x4*)q0p, *(const LAS s16x4*)(q0p + 32), 0, 1, 2, 3, 4, 5, 6, 7);
                  const bf16x8 qb1 = __builtin_shufflevector(*(const LAS s16x4*)q1p, *(const LAS s16x4*)(q1p + 32), 0, 1, 2, 3, 4, 5, 6, 7);
                  oT0 = MFMA16(sa, qb0, oT0); oT1 = MFMA16(sa, qb1, oT1); }
              { bf16_t* op = PB + (size_t)(crow0 + fr) * 4096 + 1024 + h * 128 + 16 * wid + 4 * q; u32x2 w; w.x = pk2(oT0[0], oT0[1]); w.y = pk2(oT0[2], oT0[3]); *(u32x2*)op = w;
                w.x = pk2(oT1[0], oT1[1]); w.y = pk2(oT1[2], oT1[3]); *(u32x2*)(op + (size_t)16 * 4096) = w; }
              const bf16x8 vb = __builtin_shufflevector(vtr(vcol + (8 * q) * 272), vtr(vcol + (8 * q + 4) * 272), 0, 1, 2, 3, 4, 5, 6, 7);
#pragma unroll
              for (int kt = 0; kt < 8; ++kt) { const LAS unsigned char* kc = KH + (8 * q + (fr >> 2)) * 272 + (16 * kt + 4 * (fr & 3)) * 2;
                  const bf16x8 ka = __builtin_shufflevector(vtr(kc), vtr(kc + 4 * 272), 0, 1, 2, 3, 4, 5, 6, 7); const f32x4 ed = *(const LAS f32x4*)(ED + 16 * kt + 4 * q);
                  S[kt] = MFMA16(ka, vb, S[kt] * ed); } }
        }
#pragma unroll
        for (int kt = 0; kt < 8; ++kt)
#pragma unroll
            for (int j = 0; j < 4; ++j) DS[((size_t)u * 128 + 16 * kt + 4 * q + j) * 128 + 16 * wid + fr] = S[kt][j];
        __syncthreads();
        if (tid < 128) DSEG[u * 128 + tid] = __expf(BP[tid]);
        __syncthreads();
    }
}
__device__ __forceinline__ void hgrn_x3(LAS unsigned char* lds, PP p, const float* gnorm, const int tid, const int bid, const int nblk) {
    bf16_t* PB = (bf16_t*)(p->ws + WS_BIG); const float* DS = (const float*)(p->ws + WS_DS); const float* DSEG = (const float*)(p->ws + WS_DSEG);
    LAS unsigned char* ST = lds;
    const int lane = tid & 63, wid = __builtin_amdgcn_readfirstlane(tid >> 6), fr = lane & 15, q = lane >> 4;
    for (int u = bid; u < 256; u += nblk) {
        const int h = u >> 5, sg = u & 31, row0 = sg * 512;
        { const int k = tid & 127, vg = tid >> 7; float acc[32];
#pragma unroll
          for (int i = 0; i < 32; ++i) acc[i] = 0.f;
          float P = 1.f;
          for (int j = sg - 1; j >= 0; --j) { const f32x4* src = (const f32x4*)(DS + ((size_t)((h * 32 + j) * 128 + k)) * 128 + 32 * vg);
#pragma unroll
              for (int i = 0; i < 8; ++i) { const f32x4 v = src[i]; acc[4 * i] += P * v[0]; acc[4 * i + 1] += P * v[1]; acc[4 * i + 2] += P * v[2]; acc[4 * i + 3] += P * v[3]; }
              P *= DSEG[(h * 32 + j) * 128 + k];
              if (!__syncthreads_or(P != 0.f ? 1 : 0)) break; }
#pragma unroll
          for (int i = 0; i < 32; ++i) *(LAS bf16_t*)(ST + (32 * vg + i) * 272 + k * 2) = (bf16_t)(pk2(acc[i], 0.f) & 0xffffu); }
        __syncthreads();
        bf16x8 bqn[4]; u32x4 oln[4], gvn[4];
        { const bf16_t* rp = PB + (size_t)(row0 + 64 * wid + fr) * 4096 + h * 128;
#pragma unroll
          for (int kk = 0; kk < 4; ++kk) bqn[kk] = *(const bf16x8*)(rp + 32 * kk + 8 * q);
#pragma unroll
          for (int pp = 0; pp < 4; ++pp) { oln[pp] = *(const u32x4*)(rp + 1024 + 32 * pp + 8 * q); gvn[pp] = *(const u32x4*)(rp + 3072 + 32 * pp + 8 * q); } }
#pragma unroll
        for (int tb = 0; tb < 4; ++tb) { const int t = row0 + 64 * wid + 16 * tb + fr; bf16_t* rowp = PB + (size_t)t * 4096 + h * 128;
            bf16x8 bq[4]; u32x4 olv[4], gvv[4];
#pragma unroll
            for (int kk = 0; kk < 4; ++kk) bq[kk] = bqn[kk];
#pragma unroll
            for (int pp = 0; pp < 4; ++pp) { olv[pp] = oln[pp]; gvv[pp] = gvn[pp]; }
            if (tb < 3) { const bf16_t* rp = rowp + (size_t)16 * 4096;
#pragma unroll
                for (int kk = 0; kk < 4; ++kk) bqn[kk] = *(const bf16x8*)(rp + 32 * kk + 8 * q);
#pragma unroll
                for (int pp = 0; pp < 4; ++pp) { oln[pp] = *(const u32x4*)(rp + 1024 + 32 * pp + 8 * q); gvn[pp] = *(const u32x4*)(rp + 3072 + 32 * pp + 8 * q); } }
            f32x4 oT[8];
#pragma unroll
            for (int vt = 0; vt < 8; ++vt) oT[vt] = (f32x4){0.f, 0.f, 0.f, 0.f};
            if (sg > 0) {
#pragma unroll
                for (int kk = 0; kk < 4; ++kk) {
#pragma unroll
                    for (int vt = 0; vt < 8; ++vt) { const int vrow = 32 * (vt >> 1) + 8 * (fr >> 2) + 4 * (vt & 1) + (fr & 3);
                        const bf16x8 sa = *(const LAS bf16x8*)(ST + vrow * 272 + kk * 64 + q * 16); oT[vt] = MFMA16(sa, bq[kk], oT[vt]); } } }
            float ss = 0.f;
#pragma unroll
            for (int pp = 0; pp < 4; ++pp) { const u32x4 ol = olv[pp];
                oT[2 * pp][0] += bf_lo(ol.x); oT[2 * pp][1] += bf_hi(ol.x); oT[2 * pp][2] += bf_lo(ol.y); oT[2 * pp][3] += bf_hi(ol.y);
                oT[2 * pp + 1][0] += bf_lo(ol.z); oT[2 * pp + 1][1] += bf_hi(ol.z); oT[2 * pp + 1][2] += bf_lo(ol.w); oT[2 * pp + 1][3] += bf_hi(ol.w); }
#pragma unroll
            for (int vt = 0; vt < 8; ++vt) ss += (oT[vt][0] * oT[vt][0] + oT[vt][1] * oT[vt][1]) + (oT[vt][2] * oT[vt][2] + oT[vt][3] * oT[vt][3]);
            ss += __shfl_xor(ss, 16); ss += __shfl_xor(ss, 32);
            const float rstd = rsqrtf(ss * (1.f / 128.f) + EPS);
#pragma unroll
            for (int pp = 0; pp < 4; ++pp) { const u32x4 gv = gvv[pp]; const f32x4 g0 = *(const f32x4*)(gnorm + h * 128 + 32 * pp + 8 * q), g1 = *(const f32x4*)(gnorm + h * 128 + 32 * pp + 8 * q + 4);
                u32x4 w;
                w.x = pk2(oT[2 * pp][0] * rstd * g0[0] * bf_lo(gv.x), oT[2 * pp][1] * rstd * g0[1] * bf_hi(gv.x)); w.y = pk2(oT[2 * pp][2] * rstd * g0[2] * bf_lo(gv.y), oT[2 * pp][3] * rstd * g0[3] * bf_hi(gv.y));
                w.z = pk2(oT[2 * pp + 1][0] * rstd * g1[0] * bf_lo(gv.z), oT[2 * pp + 1][1] * rstd * g1[1] * bf_hi(gv.z)); w.w = pk2(oT[2 * pp + 1][2] * rstd * g1[2] * bf_lo(gv.w), oT[2 * pp + 1][3] * rstd * g1[3] * bf_hi(gv.w));
                *(u32x4*)(rowp + 2048 + 32 * pp + 8 * q) = w; } }
        __syncthreads();
    }
}

#ifndef PHASE_TABLE
#define PHASE_TABLE
constexpr int NPHASE = 24;
__constant__ unsigned char PH_KIND[NPHASE] = {0, 1, 2, 6, 7, 8, 1, 3, 4, 6, 7, 8, 1, 5, 2, 6, 7, 8, 1, 2, 6, 7, 8, 9};
__constant__ unsigned char PH_L[NPHASE]    = {0, 0, 0, 0, 0, 0, 1, 1, 1, 1, 1, 1, 2, 2, 2, 2, 2, 2, 3, 3, 3, 3, 3, 3};
#endif
__global__ void __launch_bounds__(NTHR, 2) fwd_megakernel(Params p_unused) {
    extern __shared__ __attribute__((aligned(16))) unsigned char lds_raw[];
    LAS unsigned char* lds = (LAS unsigned char*)lds_raw;
    cg::grid_group grid = cg::this_grid();
    { PP p0 = (PP)__builtin_amdgcn_kernarg_segment_ptr(); if (threadIdx.x < 16) ((LAS unsigned*)(lds + LDS_CTL))[threadIdx.x] = 0u; __syncthreads();
      (void)xcd_barrier_post((unsigned*)(p0->ws + WS_BAR), (volatile LAS unsigned*)(lds + LDS_CTL)); }
    for (int ph = 0; ph < NPHASE; ++ph) {
        PP p = (PP)__builtin_amdgcn_kernarg_segment_ptr(); asm volatile("" : "+s"(p));
        const int kind = PH_KIND[ph], L = PH_L[ph], mix = L % 3, jx = L / 3;
        int tid = threadIdx.x, bid = blockIdx.x, nblk = gridDim.x; asm volatile("" : "+v"(tid), "+s"(bid), "+s"(nblk));
        const int lane = tid & 63, wave = __builtin_amdgcn_readfirstlane(tid >> 6);
        const int gw = bid * NWV + wave, ngw = nblk * NWV;
        LAS float* scr = (LAS float*)(lds + wave * CONV_SCR_BYTES);
        bf16_t* BIG = (bf16_t*)(p->ws + WS_BIG); bf16_t* XB = (bf16_t*)(p->ws + WS_XB); bf16_t* WMIX = (bf16_t*)(p->ws + ((L & 1) ? WS_WMIX2 : WS_WMIX)); bf16_t* WMLP = (bf16_t*)(p->ws + WS_WMLP);
        float* SSQ = (float*)(p->ws + WS_SSQ);
        if (kind == 0) {
            conv_mix(p, 0, scr, gw, ngw, lane);
            { f32x4 nv[4] = {{0.f, 0.f, 0.f, 0.f}, {0.f, 0.f, 0.f, 0.f}, {0.f, 0.f, 0.f, 0.f}, {0.f, 0.f, 0.f, 0.f}};
              if (gw < T) { const f32x4* xr = (const f32x4*)(p->in[0] + (size_t)gw * D) + lane;
#pragma unroll
                  for (int j = 0; j < 4; ++j) nv[j] = __builtin_nontemporal_load(xr + 64 * j); }
              for (int m = gw; m < T; m += ngw) { f32x4 v[4]; float s = 0.f;
#pragma unroll
                  for (int j = 0; j < 4; ++j) v[j] = nv[j];
                  if (m + ngw < T) { const f32x4* xr = (const f32x4*)(p->in[0] + (size_t)(m + ngw) * D) + lane;
#pragma unroll
                      for (int j = 0; j < 4; ++j) nv[j] = __builtin_nontemporal_load(xr + 64 * j); }
#pragma unroll
                  for (int j = 0; j < 4; ++j) s += (v[j][0] * v[j][0] + v[j][1] * v[j][1]) + (v[j][2] * v[j][2] + v[j][3] * v[j][3]);
                  s = wave_sum(s); if (lane < 16) SSQ[(size_t)m * 16 + lane] = (lane == 0) ? s : 0.f;
                  u32x2* o = (u32x2*)(XB + (size_t)m * D) + lane;
#pragma unroll
                  for (int j = 0; j < 4; ++j) { u32x2 w; w.x = pk2(v[j][0], v[j][1]); w.y = pk2(v[j][2], v[j][3]); o[64 * j] = w; } } }
        } else if (kind == 1 || kind == 7) {
            if (kind == 7 && L < 3 && L != 0) { conv_mix(p, L + 1, scr, gw, ngw, lane); __syncthreads(); }
            if (kind == 1 && mix == 0) {
                const int lo = (384 - nblk > 0 && 384 - nblk < nblk) ? 384 - nblk : 0;
                if (bid >= lo) { conv_mlp(p, L, scr, (bid - lo) * NWV + wave, (nblk - lo) * NWV, lane);
                    if (L == 0) conv_mix(p, 1, scr, (bid - lo) * NWV + wave, (nblk - lo) * NWV, lane); }
                __syncthreads(); }
            if (kind == 1 && mix == 2) fox_flog(p, SSQ + (size_t)(2 * L) * T * 16, p->in[15] + jx * 3088 + 3072, gw, ngw, lane);
            const float* sq = SSQ + (size_t)((kind == 7) ? 2 * L + 1 : 2 * L) * T * 16;
            const int ncols = (kind == 7 || mix == 1) ? 4096 : (mix == 0 ? 1536 : 3072);
            int pmc = -1;
            { const int nN = ncols / 256, nwg = 64 * nN; if (bid < nwg) { const int qq = nwg / 8, rr = nwg % 8, xcd = bid % 8, off = bid / 8;
                const int wgid = (xcd < rr ? xcd * (qq + 1) : rr * (qq + 1) + (xcd - rr) * qq) + off; const int nig = 8 * nN, fm = (wgid / nig) * 8, gsz = (64 - fm) < 8 ? (64 - fm) : 8;
                pmc = fm + ((wgid % nig) % gsz); } }
            LAS float* rsl = (LAS float*)(lds + 131072);
            if (tid < 256 && pmc >= 0) rsl[tid] = row_rstd(sq, pmc * 256 + tid);
            __syncthreads();
            if (kind == 7 || mix == 1) { pg8::EpiAct E;
                if (kind == 7) E = pg8::EpiAct{BIG, nullptr, sq, 0x55555555u  , 0, 1.f, rsl, pmc};
                else E = pg8::EpiAct{BIG, nullptr, sq, 0xAA0000AAu  , 0, 1.f, rsl, pmc};
                run_gemm<pg8::EpiAct, 4096, 1024, 1024>(lds, XB, (kind == 7) ? WMLP : WMIX, E, tid, bid, nblk); }
            else if (mix == 0) { pg8::EpiAct E{BIG, p->in[7] + jx * 1536, sq, 0u, 4, 0.125f * LOG2E, rsl, pmc}; run_gemm<pg8::EpiAct, 1536, 1024, 1024>(lds, XB, WMIX, E, tid, bid, nblk); }
            else { pg8::EpiAct E{BIG, p->in[15] + jx * 3088, sq, 0u, 4, 0.125f * LOG2E, rsl, pmc}; run_gemm<pg8::EpiAct, 3072, 1024, 1024>(lds, XB, WMIX, E, tid, bid, nblk); }
        } else if (kind == 6 || kind == 8) {
            pg8::EpiResid E; const bf16_t* A; const bf16_t* Bt;
            if (kind == 8) { E = pg8::EpiResid{XB, SSQ + (size_t)(2 * L + 2) * T * 16}; run_gemm<pg8::EpiResid, 1024, 4096, 4096>(lds, BIG, WMLP + 4096 * 1024, E, tid, bid, nblk); }
            else { E = pg8::EpiResid{XB, SSQ + (size_t)(2 * L + 1) * T * 16};
                if (mix == 0) { A = BIG + 2048; Bt = WMIX + 1536 * 1024; } else if (mix == 1) { A = BIG + 2048; Bt = WMIX + 4096 * 1024; } else { A = BIG + 3072; Bt = WMIX + 3072 * 1024; }
                run_gemm<pg8::EpiResid, 1024, 1024, 4096>(lds, A, Bt, E, tid, bid, nblk); }
        } else if (kind == 2) {
            if (mix != 0) { conv_mlp(p, L, scr, gw, ngw, lane); __syncthreads(); }
            if (mix == 0) swa_phase(lds, BIG, p->in[8] + jx * 16, tid, bid, nblk);
            else { AttnCfg c{BIG, 4096, 1024, 2048, 3072, 1, nullptr, (const float*)(p->ws + WS_C2), (const float*)(p->ws + WS_PK), (const float*)(p->ws + WS_SEG)}; attn_phase(lds, c, tid, bid, nblk); }
        } else if (kind == 3) {
            conv_mlp(p, L, scr, gw, ngw, lane); __syncthreads();
            hgrn_x1(lds, p, L, tid, bid, nblk);
        } else if (kind == 4) {
            hgrn_x3(lds, p, p->in[12] + jx * 1024, tid, bid, nblk);
        } else if (kind == 5) {
            fox_scan(lds, p, tid, bid, nblk);
        } else if (kind == 9) {
            const float* ssq = SSQ + (size_t)8 * T * 16; const float* gf = p->in[3];
            { u32x2 nb[4] = {{0u, 0u}, {0u, 0u}, {0u, 0u}, {0u, 0u}}; float nrs = 0.f;
              if (gw < T) { const u32x2* xs = (const u32x2*)(XB + (size_t)gw * D) + lane; nrs = row_rstd(ssq, gw);
#pragma unroll
                  for (int j = 0; j < 4; ++j) nb[j] = xs[64 * j]; }
              for (int m = gw; m < T; m += ngw) { f32x4* xr = (f32x4*)(p->out + (size_t)m * D) + lane; u32x2 b[4]; const float rs = nrs;
#pragma unroll
                  for (int j = 0; j < 4; ++j) b[j] = nb[j];
                  if (m + ngw < T) { const u32x2* xs = (const u32x2*)(XB + (size_t)(m + ngw) * D) + lane; nrs = row_rstd(ssq, m + ngw);
#pragma unroll
                      for (int j = 0; j < 4; ++j) nb[j] = xs[64 * j]; }
#pragma unroll
                  for (int j = 0; j < 4; ++j) { const f32x4 g = *((const f32x4*)gf + lane + 64 * j);
                      f32x4 v = {bf_lo(b[j].x), bf_hi(b[j].x), bf_lo(b[j].y), bf_hi(b[j].y)}; v = v * rs * g; __builtin_nontemporal_store(v, xr + 64 * j); } } }
        }
        if (ph + 1 < NPHASE) {
            if (p->ws == nullptr) {
                grid.sync();
            } else {
                XcdBarrier xb; xb.bar = (unsigned*)(p->ws + WS_BAR); xb.x = xb_xcc_id(); xb.st = (volatile LAS unsigned*)(lds + LDS_CTL);
                xcd_barrier(xb);
            }
        }
    }
}

extern "C" void kernel_launch(void* const* d_in, const int* in_sizes, int n_in, void* d_out, int out_size, void* d_ws, size_t ws_size, hipStream_t stream) {
    static int grid_blocks = 0;
    if (grid_blocks == 0) {
        if (n_in != 17 || out_size != T * D || ws_size < WS_END) { fprintf(stderr, "kernel_launch: unexpected shapes (n_in %d out %d ws %zu)\n", n_in, out_size, ws_size); grid_blocks = -1; return; }
        int dev = 0, cus = 0, per_cu = 0;
        (void)hipGetDevice(&dev); (void)hipDeviceGetAttribute(&cus, hipDeviceAttributeMultiprocessorCount, dev);
        (void)hipFuncSetAttribute((const void*)fwd_megakernel, hipFuncAttributeMaxDynamicSharedMemorySize, LDS_BYTES);
        (void)hipOccupancyMaxActiveBlocksPerMultiprocessor(&per_cu, (const void*)fwd_megakernel, NTHR, LDS_BYTES);
        if (per_cu < 1) per_cu = 1;
        grid_blocks = cus * 1;
        (void)hipGetLastError();
    }
    if (grid_blocks < 0) return;
    (void)hipMemsetAsync((char*)d_ws + WS_BAR, 0, 16384, stream);
    Params p{};
    for (int i = 0; i < 17; ++i) p.in[i] = (const float*)d_in[i];
    p.out = (float*)d_out; p.ws = (unsigned char*)d_ws;
    void* args[] = {&p};
    hipError_t e = hipLaunchCooperativeKernel((const void*)fwd_megakernel, dim3(grid_blocks), dim3(NTHR), args, LDS_BYTES, stream);
    if (e != hipSuccess) fprintf(stderr, "cooperative launch failed: %s (grid %d)\n", hipGetErrorString(e), grid_blocks);
}
```

```cpp
#include <hip/hip_runtime.h>
#include <hip/hip_cooperative_groups.h>
#include <cstdio>
#include <cstdint>
namespace cg = cooperative_groups;
namespace pg8 {
#define PG8_LAS __attribute__((address_space(3)))
typedef unsigned short bf16_t;
typedef short bf16x8 __attribute__((ext_vector_type(8)));
typedef float f32x4 __attribute__((ext_vector_type(4)));
typedef unsigned u32x4 __attribute__((ext_vector_type(4)));
constexpr int BM = 256, BK = 64, HALF = 128, HTB = HALF * BK * 2  , STAGE_BYTES = 8 * HTB, NXCD = 8, WGM = 8;

__host__ __device__ __forceinline__ int lds_byte(int r, int c) { const int st = (r >> 4) * 2 + (c >> 5), rr = r & 15, cc = c & 31, ob = rr * 64 + cc * 2; return st * 1024 + (ob ^ (((ob >> 9) & 1) << 5)); }
__host__ __device__ __forceinline__ void stage_rc(int b, int& R, int& C) { const int st = b / 1024, sb = b % 1024, swz = sb ^ (((sb >> 9) & 1) << 5); R = (st >> 1) * 16 + swz / 64; C = (st & 1) * 32 + (swz % 64) / 2; }
__host__ __device__ __forceinline__ int perm32(int rho) { const int n = rho >> 4, i = rho & 15; return 8 * (i >> 2) + 4 * n + (i & 3); }

struct Unit { int pm, pn; };
struct Gemm { const bf16_t* A; const bf16_t* Bt; int M, N, K, lda; };

struct StaticOrder {
    int nM, nN, nwg, G, c;
    __host__ __device__ void init(int M, int N, int G_, int c_) { nM = M / BM; nN = N / BM; nwg = nM * nN; G = G_; c = c_; }
    __host__ __device__ bool next(int i, Unit& u) const {
        const long L = (long)i * G + c; if (L >= nwg) return false;
        int wgid = (int)L; { const int q = nwg / NXCD, r = nwg % NXCD, xcd = wgid % NXCD, off = wgid / NXCD; wgid = (xcd < r ? xcd * (q + 1) : r * (q + 1) + (xcd - r) * q) + off; }
        const int nig = WGM * nN, gid = wgid / nig, fm = gid * WGM, gsz = (nM - fm) < WGM ? (nM - fm) : WGM;
        u.pm = fm + ((wgid % nig) % gsz); u.pn = (wgid % nig) / gsz; return true;
    }
    __device__ __forceinline__ void a_ready(const Unit&) const {}
    __device__ __forceinline__ void done(const Unit&) const {}
};

typedef float f32x2_t __attribute__((ext_vector_type(2))); typedef __bf16 bf16x2_t __attribute__((ext_vector_type(2)));
typedef unsigned u32x2 __attribute__((ext_vector_type(2)));
__device__ __forceinline__ unsigned pk2(float lo, float hi) { f32x2_t v = {lo, hi}; bf16x2_t b = __builtin_convertvector(v, bf16x2_t); return __builtin_bit_cast(unsigned, b); }
__device__ __forceinline__ float row_rstd(const float* ssqp, int row) {
    const f32x4* q = (const f32x4*)(ssqp + (size_t)row * 16); const f32x4 a = q[0], b = q[1], c = q[2], d = q[3];
    const float s = (((a[0] + a[1]) + (a[2] + a[3])) + ((b[0] + b[1]) + (b[2] + b[3]))) + (((c[0] + c[1]) + (c[2] + c[3])) + ((d[0] + d[1]) + (d[2] + d[3])));
    return rsqrtf(s * (1.f / 1024.f) + 1e-6f);
}
__device__ __forceinline__ float act1(float v, int a) {
    if (a == 1) { const float r = v > 0.f ? v : 0.f; return r * r; }
    if (a == 2) { return v * __builtin_amdgcn_rcpf(1.f + __expf(-v)); }
    return v;
}
struct EpiAct {
    static constexpr bool PERM = true, AFTER_DRAIN = false;
    bf16_t* O; const float* bias; const float* ssq; unsigned actmask; int nscale; float scale0;
    const PG8_LAS float* rsl; int pmc;
    template <int ACT> __device__ __forceinline__ void body(const f32x4 (&acc)[2][2][4][2], const Unit& u, int wr, int wc, int fr, int fq) const {
        const int row0 = u.pm * BM + wr * 64 + fr, col0 = u.pn * BM + wc * 32 + 8 * fq;
        const float sc = (u.pn < nscale) ? scale0 : 1.f;
        f32x4 bv[2][2];
#pragma unroll
        for (int bj = 0; bj < 2; ++bj)
#pragma unroll
            for (int n = 0; n < 2; ++n) bv[bj][n] = bias ? *(const f32x4*)(bias + col0 + bj * HALF + 4 * n) : (f32x4){0.f, 0.f, 0.f, 0.f};
#pragma unroll
        for (int ai = 0; ai < 2; ++ai)
#pragma unroll
            for (int m = 0; m < 4; ++m) { const int row = row0 + ai * HALF + m * 16; const float rs = (u.pm == pmc) ? rsl[row & 255] : row_rstd(ssq, row);
                bf16_t* rowp = O + (size_t)row * 4096 + col0;
#pragma unroll
                for (int bj = 0; bj < 2; ++bj) { f32x4 v0 = acc[ai][bj][m][0] * rs + bv[bj][0], v1 = acc[ai][bj][m][1] * rs + bv[bj][1];
                    if (ACT != 0) {
#pragma unroll
                        for (int e = 0; e < 4; ++e) { v0[e] = act1(v0[e], ACT); v1[e] = act1(v1[e], ACT); } }
                    v0 = v0 * sc; v1 = v1 * sc; u32x4 w; w.x = pk2(v0[0], v0[1]); w.y = pk2(v0[2], v0[3]); w.z = pk2(v1[0], v1[1]); w.w = pk2(v1[2], v1[3]);
                    *(u32x4*)(rowp + bj * HALF) = w; } }
    }
    __device__ __forceinline__ void operator()(const f32x4 (&acc)[2][2][4][2], const Unit& u, int wr, int wc, int fr, int fq) const {
        const int act = (int)((actmask >> (2 * u.pn)) & 3u);
        if (act == 1) body<1>(acc, u, wr, wc, fr, fq); else if (act == 2) body<2>(acc, u, wr, wc, fr, fq); else body<0>(acc, u, wr, wc, fr, fq);
    }
};
struct EpiResid {
    static constexpr bool PERM = true, AFTER_DRAIN = false;
    bf16_t* xb; float* ssq;
    __device__ __forceinline__ void operator()(const f32x4 (&acc)[2][2][4][2], const Unit& u, int wr, int wc, int fr, int fq) const {
        const int col0 = u.pn * BM + wc * 32 + 8 * fq;
#pragma unroll
        for (int ai = 0; ai < 2; ++ai) {
            u32x4 bv[4][2];
#pragma unroll
            for (int m = 0; m < 4; ++m) { const size_t off = (size_t)(u.pm * BM + ai * HALF + wr * 64 + m * 16 + fr) * 1024 + col0;
#pragma unroll
                for (int bj = 0; bj < 2; ++bj) bv[m][bj] = *(const u32x4*)(xb + off + bj * HALF); }
#pragma unroll
            for (int m = 0; m < 4; ++m) { const int row = u.pm * BM + ai * HALF + wr * 64 + m * 16 + fr; const size_t off = (size_t)row * 1024 + col0; float s = 0.f;
#pragma unroll
                for (int bj = 0; bj < 2; ++bj) { const u32x4 b = bv[m][bj]; const f32x4 a0 = acc[ai][bj][m][0], a1 = acc[ai][bj][m][1];
                    const float x0 = __uint_as_float(b.x << 16) + a0[0], x1 = __uint_as_float(b.x & 0xffff0000u) + a0[1], x2 = __uint_as_float(b.y << 16) + a0[2], x3 = __uint_as_float(b.y & 0xffff0000u) + a0[3];
                    const float x4 = __uint_as_float(b.z << 16) + a1[0], x5 = __uint_as_float(b.z & 0xffff0000u) + a1[1], x6 = __uint_as_float(b.w << 16) + a1[2], x7 = __uint_as_float(b.w & 0xffff0000u) + a1[3];
                    u32x4 w; w.x = pk2(x0, x1); w.y = pk2(x2, x3); w.z = pk2(x4, x5); w.w = pk2(x6, x7); *(u32x4*)(xb + off + bj * HALF) = w;
                    s += ((x0 * x0 + x1 * x1) + (x2 * x2 + x3 * x3)) + ((x4 * x4 + x5 * x5) + (x6 * x6 + x7 * x7)); }
                s += __shfl_xor(s, 16); s += __shfl_xor(s, 32);
                if (fq == 0) ssq[(size_t)row * 16 + u.pn * 4 + wc] = s; } }
    }
};

template <class Epi, class Sched, int KC, int LDA, bool ALIGN_EPI = false, bool SP2 = false>
__device__ __forceinline__ void gemm_phase(PG8_LAS unsigned char* lds, const Gemm g, const Sched& S, const Epi& E, const int tid) {
    const int wid = __builtin_amdgcn_readfirstlane(tid >> 6), lane = tid & 63, wr = wid >> 2, wc = wid & 3, fr = lane & 15, fq = lane >> 4;
    constexpr int K = KC, nt = KC / BK;
    unsigned voffA[2], voffB[2];
#pragma unroll
    for (int i = 0; i < 2; ++i) { int R, C; stage_rc(tid * 16 + i * 8192, R, C); const int Rb = Epi::PERM ? ((R & ~31) + perm32(R & 31)) : R;
        voffA[i] = (unsigned)(R * LDA + C) * 2u; voffB[i] = (unsigned)(Rb * K + C) * 2u; }
    const size_t kstep = (size_t)(BK * 2);
    const size_t hstepA = (size_t)HALF * LDA * 2, hstepB = (size_t)HALF * K * 2;
    const size_t tstepA = 2 * hstepA, tstepB = 2 * hstepB;
    const unsigned ldsw = (unsigned)wid * 1024u;
    const int aoff = lds_byte(wr * 64 + fr, fq * 8), boff = lds_byte(wc * 32 + fr, fq * 8);
#define PG8_SA(b, h) (((b) * 2 + (h)) * HTB)
#define PG8_SB(b, h) ((4 + (b) * 2 + (h)) * HTB)
#define PG8_STAGE(bufoff, gbase, voff) do { _Pragma("unroll") for (int _i = 0; _i < 2; ++_i) \
        __builtin_amdgcn_global_load_lds((const unsigned*)((const char*)(gbase) + (voff)[_i]), (PG8_LAS unsigned*)(lds + (bufoff) + ldsw + _i * 8192), 16, 0, 0); } while (0)
#define PG8_LDA(dst, b, h) do { _Pragma("unroll") for (int m = 0; m < 4; ++m) _Pragma("unroll") for (int k = 0; k < 2; ++k) dst[m][k] = *(const PG8_LAS bf16x8*)(lds + PG8_SA(b, h) + aoff + m * 2048 + k * 1024); } while (0)
#define PG8_LDB(dst, b, h) do { _Pragma("unroll") for (int n = 0; n < 2; ++n) _Pragma("unroll") for (int k = 0; k < 2; ++k) dst[n][k] = *(const PG8_LAS bf16x8*)(lds + PG8_SB(b, h) + boff + n * 2048 + k * 1024); } while (0)
#define PG8_MMA(ai, bj, At, Bt) do { __builtin_amdgcn_s_setprio(1); _Pragma("unroll") for (int m = 0; m < 4; ++m) _Pragma("unroll") for (int n = 0; n < 2; ++n) _Pragma("unroll") for (int k = 0; k < 2; ++k) \
        acc[ai][bj][m][n] = __builtin_amdgcn_mfma_f32_16x16x32_bf16(Bt[n][k], At[m][k], acc[ai][bj][m][n], 0, 0, 0); __builtin_amdgcn_s_setprio(0); } while (0)
#define PG8_WAIT_V(n) asm volatile("s_waitcnt vmcnt(" #n ")" ::: "memory")
#define PG8_WAIT_L(n) asm volatile("s_waitcnt lgkmcnt(" #n ")" ::: "memory")
#define PG8_BAR __builtin_amdgcn_s_barrier()
#define PG8_SCHED __builtin_amdgcn_sched_barrier(0)
    Unit cur, nxt; int ui = 0;
    if (!S.next(0, cur)) return;
    f32x4 acc[2][2][4][2];
#pragma unroll
    for (int a = 0; a < 2; ++a)
#pragma unroll
        for (int b = 0; b < 2; ++b)
#pragma unroll
            for (int m = 0; m < 4; ++m)
#pragma unroll
                for (int n = 0; n < 2; ++n) acc[a][b][m][n] = (f32x4){0.f, 0.f, 0.f, 0.f};
    bf16x8 At[4][2], B0[2][2], B1[2][2];
    const char* cA = (const char*)g.A + (size_t)cur.pm * tstepA; const char* cB = (const char*)g.Bt + (size_t)cur.pn * tstepB;
    S.a_ready(cur);
    if constexpr (SP2) {
        PG8_STAGE(PG8_SB(0, 0), cB, voffB); PG8_STAGE(PG8_SB(0, 1), cB + hstepB, voffB); PG8_STAGE(PG8_SA(0, 0), cA, voffA); PG8_STAGE(PG8_SA(0, 1), cA + hstepA, voffA);
        if (wr == 1) PG8_BAR;
        PG8_WAIT_V(2); PG8_BAR;
        PG8_STAGE(PG8_SB(1, 0), cB + kstep, voffB); PG8_STAGE(PG8_SA(1, 0), cA + kstep, voffA); PG8_STAGE(PG8_SB(1, 1), cB + hstepB + kstep, voffB);
        PG8_WAIT_V(6); PG8_BAR;
    } else {
        PG8_STAGE(PG8_SB(0, 0), cB, voffB); PG8_STAGE(PG8_SA(0, 0), cA, voffA); PG8_STAGE(PG8_SB(0, 1), cB + hstepB, voffB); PG8_STAGE(PG8_SA(0, 1), cA + hstepA, voffA);
        if (wr == 1) PG8_BAR;
        PG8_WAIT_V(4); PG8_BAR;
        PG8_STAGE(PG8_SB(1, 0), cB + kstep, voffB); PG8_STAGE(PG8_SA(1, 0), cA + kstep, voffA); PG8_STAGE(PG8_SB(1, 1), cB + hstepB + kstep, voffB);
        PG8_WAIT_V(6); PG8_BAR;
    }
    for (;;) {
        const bool has_next = S.next(ui + 1, nxt);
        const char* nA = has_next ? (const char*)g.A + (size_t)nxt.pm * tstepA : cA; const char* nB = has_next ? (const char*)g.Bt + (size_t)nxt.pn * tstepB : cB;
        for (int t = 0; t < nt; t += 2) {
            const bool last = (t == nt - 2);
            const char* a1 = cA + (size_t)(t + 1) * kstep;
            const char* a2 = last ? nA : cA + (size_t)(t + 2) * kstep; const char* b2 = last ? nB : cB + (size_t)(t + 2) * kstep;
            const char* a3 = a2 + kstep; const char* b3 = b2 + kstep;
            if (last && has_next) S.a_ready(nxt);
            if constexpr (SP2) {
            PG8_LDB(B0, 0, 0); PG8_LDB(B1, 0, 1); PG8_SCHED; PG8_LDA(At, 0, 0); PG8_STAGE(PG8_SA(1, 1), a1 + hstepA, voffA);
            PG8_WAIT_V(8); PG8_WAIT_L(0); PG8_BAR; PG8_MMA(0, 0, At, B0); PG8_MMA(0, 1, At, B1); PG8_BAR; PG8_SCHED;
            PG8_LDA(At, 0, 1); PG8_STAGE(PG8_SB(0, 0), b2, voffB); PG8_STAGE(PG8_SB(0, 1), b2 + hstepB, voffB); PG8_STAGE(PG8_SA(0, 0), a2, voffA);
            PG8_WAIT_V(8); PG8_WAIT_L(0); PG8_BAR; PG8_MMA(1, 0, At, B0); PG8_MMA(1, 1, At, B1); PG8_BAR; PG8_SCHED;
            PG8_LDB(B0, 1, 0); PG8_LDB(B1, 1, 1); PG8_SCHED; PG8_LDA(At, 1, 0); PG8_STAGE(PG8_SA(0, 1), a2 + hstepA, voffA);
            PG8_WAIT_V(8); PG8_WAIT_L(0); PG8_BAR; PG8_MMA(0, 0, At, B0); PG8_MMA(0, 1, At, B1); PG8_BAR; PG8_SCHED;
            PG8_LDA(At, 1, 1); PG8_STAGE(PG8_SB(1, 0), b3, voffB); PG8_STAGE(PG8_SB(1, 1), b3 + hstepB, voffB); PG8_STAGE(PG8_SA(1, 0), a3, voffA);
            PG8_WAIT_V(8); PG8_WAIT_L(0); PG8_BAR; PG8_MMA(1, 0, At, B0); PG8_MMA(1, 1, At, B1); PG8_BAR; PG8_SCHED;
            } else {
            PG8_LDB(B0, 0, 0); PG8_SCHED; PG8_LDA(At, 0, 0); PG8_STAGE(PG8_SA(1, 1), a1 + hstepA, voffA);
            PG8_WAIT_L(8); PG8_BAR; PG8_WAIT_L(0); PG8_MMA(0, 0, At, B0); PG8_BAR; PG8_SCHED;
            PG8_LDB(B1, 0, 1); PG8_STAGE(PG8_SB(0, 0), b2, voffB);
            PG8_BAR; PG8_WAIT_L(0); PG8_MMA(0, 1, At, B1); PG8_BAR;
            PG8_LDA(At, 0, 1); PG8_STAGE(PG8_SA(0, 0), a2, voffA);
            PG8_BAR; PG8_WAIT_L(0); PG8_MMA(1, 0, At, B0); PG8_BAR; PG8_SCHED;
            PG8_STAGE(PG8_SB(0, 1), b2 + hstepB, voffB);
            PG8_WAIT_V(6); PG8_BAR; PG8_MMA(1, 1, At, B1); PG8_BAR;
            PG8_LDB(B0, 1, 0); PG8_SCHED; PG8_LDA(At, 1, 0); PG8_STAGE(PG8_SA(0, 1), a2 + hstepA, voffA);
            PG8_WAIT_L(8); PG8_BAR; PG8_WAIT_L(0); PG8_MMA(0, 0, At, B0); PG8_BAR; PG8_SCHED;
            PG8_LDB(B1, 1, 1); PG8_STAGE(PG8_SB(1, 0), b3, voffB);
            PG8_BAR; PG8_WAIT_L(0); PG8_MMA(0, 1, At, B1); PG8_BAR;
            PG8_LDA(At, 1, 1); PG8_STAGE(PG8_SA(1, 0), a3, voffA);
            PG8_BAR; PG8_WAIT_L(0); PG8_MMA(1, 0, At, B0); PG8_BAR; PG8_SCHED;
            PG8_STAGE(PG8_SB(1, 1), b3 + hstepB, voffB);
            PG8_WAIT_V(6); PG8_BAR; PG8_MMA(1, 1, At, B1); PG8_BAR;
            }
        }
        if constexpr (ALIGN_EPI) { if (wr == 0) PG8_BAR; }
        if constexpr (!Epi::AFTER_DRAIN) { E(acc, cur, wr, wc, fr, fq); S.done(cur); }
        if (!has_next) break;
#pragma unroll
        for (int a = 0; a < 2; ++a)
#pragma unroll
            for (int b = 0; b < 2; ++b)
#pragma unroll
                for (int m = 0; m < 4; ++m)
#pragma unroll
                    for (int n = 0; n < 2; ++n) acc[a][b][m][n] = (f32x4){0.f, 0.f, 0.f, 0.f};
        cur = nxt; cA = nA; cB = nB; ++ui;
        if constexpr (ALIGN_EPI) { if (wr == 1) PG8_BAR; }
    }
    PG8_WAIT_V(0);
    if constexpr (!ALIGN_EPI) { if (wr == 0) PG8_BAR; }
    PG8_BAR;
    if constexpr (Epi::AFTER_DRAIN) { E.fused(acc, cur, wr, wc, fr, fq, lds, wid, lane); S.done(cur); }
#undef PG8_SA
#undef PG8_SB
#undef PG8_STAGE
#undef PG8_LDA
#undef PG8_LDB
#undef PG8_MMA
#undef PG8_WAIT_V
#undef PG8_WAIT_L
#undef PG8_BAR
#undef PG8_SCHED
}
}
#define LAS __attribute__((address_space(3)))
typedef unsigned short bf16_t;
typedef short bf16x8 __attribute__((ext_vector_type(8)));
typedef short s16x4 __attribute__((ext_vector_type(4)));
typedef float f32x4 __attribute__((ext_vector_type(4)));
typedef float f32x16 __attribute__((ext_vector_type(16)));
typedef unsigned u32x4 __attribute__((ext_vector_type(4)));
typedef unsigned u32x2 __attribute__((ext_vector_type(2)));
using pg8::pk2; using pg8::row_rstd;
#define MFMA16(a, b, c) __builtin_amdgcn_mfma_f32_16x16x32_bf16((a), (b), (c), 0, 0, 0)
#define MFMA32(a, b, c) __builtin_amdgcn_mfma_f32_32x32x16_bf16((a), (b), (c), 0, 0, 0)

constexpr int T = 16384, D = 1024, FF = 4096, NTHR = 512, NWV = 8;
constexpr float EPS = 1e-6f, LOG2E = 1.4426950408889634f;
constexpr size_t MiB = 1u << 20;
constexpr size_t WS_BIG = 0, WS_XB = 128 * MiB, WS_WMIX = 160 * MiB, WS_WMLP = 172 * MiB, WS_DS = 188 * MiB, WS_MISC = 204 * MiB;
constexpr size_t WS_SSQ = WS_MISC  , WS_LF = WS_MISC + 9 * MiB, WS_C2 = WS_MISC + 10 * MiB, WS_PK = WS_MISC + 11 * MiB, WS_DSEG = WS_MISC + 12 * MiB, WS_SEG = WS_MISC + 13 * MiB  , WS_BAR = WS_MISC + 14 * MiB  , WS_END = WS_MISC + 15 * MiB;
constexpr int LDS_CTL = 8 * 17664;
constexpr int LDS_BYTES = 8 * 17664 + 1024;

struct Params { const float* in[17]; float* out; unsigned char* ws; };
typedef const __attribute__((address_space(4))) Params* PP;

__device__ __forceinline__ float bf_lo(unsigned w) { return __uint_as_float(w << 16); }
__device__ __forceinline__ float bf_hi(unsigned w) { return __uint_as_float(w & 0xffff0000u); }
__device__ __forceinline__ float bf_get(const u32x4& v, int i) { const unsigned w = v[i >> 1]; return (i & 1) ? bf_hi(w) : bf_lo(w); }
__device__ __forceinline__ float wave_sum(float v) {
#pragma unroll
    for (int o = 1; o < 64; o <<= 1) v += __shfl_xor(v, o);
    return v;
}
#define LDS_WAIT() asm volatile("s_waitcnt lgkmcnt(0)" ::: "memory")
#define LBAR() do { asm volatile("s_waitcnt lgkmcnt(0)" ::: "memory"); __builtin_amdgcn_s_barrier(); asm volatile("" ::: "memory"); } while (0)

#define RLX_AGENT __ATOMIC_RELAXED, __HIP_MEMORY_SCOPE_AGENT
#define XB_TMO      128
#define XB_XCNT(j)  (256  + 64 * (j))
#define XB_XSUB(j)  (1280 + 64 * (j))
#define XB_XGEN(j)  (2304 + 64 * (j))
#define XB_TOP      3328
#define XB_TOPGEN   3392
#define XCD_BAR_WORDS 3456
#define XB_SPIN_CAP (1u << 18)

__device__ __forceinline__ unsigned xb_ld(unsigned* p)              { return __hip_atomic_load(p, __ATOMIC_RELAXED, __HIP_MEMORY_SCOPE_AGENT); }
__device__ __forceinline__ unsigned xb_add(unsigned* p, unsigned v) { return __hip_atomic_fetch_add(p, v, __ATOMIC_RELAXED, __HIP_MEMORY_SCOPE_AGENT); }
__device__ __forceinline__ unsigned xb_xcc_id() { return (unsigned)__builtin_amdgcn_s_getreg((3 << 11) | 20) & 0xFu; }
#define XB_SPIN(cond, bar) do { unsigned _sp = 0; while (cond) { __builtin_amdgcn_s_sleep(1); \
    if ((++_sp & 255u) == 0u) { if (xb_ld(&(bar)[XB_TMO])) break; if (_sp > XB_SPIN_CAP) { atomicAdd(&(bar)[XB_TMO], 1u); break; } } } } while (0)

struct XcdBarrier {
    unsigned* bar; unsigned x;
    volatile LAS unsigned* st;
};

__device__ __forceinline__ XcdBarrier xcd_barrier_post(unsigned* bar, volatile LAS unsigned* st) {
    XcdBarrier b; b.bar = bar; b.x = xb_xcc_id(); b.st = st;
    if (threadIdx.x == 0) (void)xb_add(&bar[XB_XCNT(b.x)], 1u);
    return b;
}
__device__ __forceinline__ void xcd_barrier_complete(unsigned* bar, unsigned x, unsigned& nloc, unsigned& nx) {
    const unsigned G = gridDim.x * gridDim.y * gridDim.z;
    unsigned sum, cnt, mine, sp = 0u;
    for (;;) {
        sum = 0u; cnt = 0u; mine = 0u;
#pragma unroll
        for (unsigned j = 0; j < 16; ++j) { const unsigned c = xb_ld(&bar[XB_XCNT(j)]); sum += c; cnt += (c > 0u) ? 1u : 0u; mine = (j == x) ? c : mine; }
        if (sum == G) break;
        __builtin_amdgcn_s_sleep(1);
        if ((++sp & 255u) == 0u) { if (xb_ld(&bar[XB_TMO])) break; if (sp > XB_SPIN_CAP) { atomicAdd(&bar[XB_TMO], 1u); break; } }
    }
    nloc = mine > 0u ? mine : 1u; nx = cnt > 0u ? cnt : 1u;
}

__device__ __forceinline__ void xcd_barrier(const XcdBarrier& b) {
    asm volatile("s_waitcnt vmcnt(0)" ::: "memory");
    __syncthreads();
    if (threadIdx.x == 0) {
        unsigned* bar = b.bar;
        __builtin_amdgcn_s_waitcnt(0);
        unsigned nloc = b.st[0], nx = b.st[1];
        if (nloc == 0u) { xcd_barrier_complete(bar, b.x, nloc, nx); b.st[0] = nloc; b.st[1] = nx; }
        const unsigned old = xb_add(&bar[XB_XSUB(b.x)], 1u);
        const unsigned gen = old / nloc;
        if (old + 1u == (gen + 1u) * nloc) {
            __builtin_amdgcn_fence(__ATOMIC_RELEASE, "agent");
            asm volatile("s_waitcnt vmcnt(0)" ::: "memory");
            const unsigned og = xb_add(&bar[XB_TOP], 1u);
            const unsigned tg = og / nx;
            if (og + 1u == (tg + 1u) * nx) xb_add(&bar[XB_TOPGEN], 1u);
            else XB_SPIN(xb_ld(&bar[XB_TOPGEN]) == tg, bar);
            __builtin_amdgcn_fence(__ATOMIC_ACQUIRE, "agent");
            xb_add(&bar[XB_XGEN(b.x)], 1u);
            asm volatile("s_waitcnt vmcnt(0)" ::: "memory");
        } else {
            XB_SPIN(xb_ld(&bar[XB_XGEN(b.x)]) == gen, bar);
            __builtin_amdgcn_fence(__ATOMIC_ACQUIRE, "agent");
            asm volatile("s_waitcnt vmcnt(0)" ::: "memory");
        }
    }
    __syncthreads();
}

constexpr int CONV_SCR_BYTES = 17664;
__device__ __forceinline__ void conv_load(f32x4 (&v)[8], const float* W, int ldw, int kb, int nb, int lane) {
    const int k0 = 64 * kb, n0 = 32 * nb, kr = lane >> 3, nc = (lane & 7) * 4;
#pragma unroll
    for (int i = 0; i < 8; ++i) v[i] = __builtin_nontemporal_load((const f32x4*)(W + (size_t)(k0 + 8 * i + kr) * ldw + n0 + nc));
}
__device__ __forceinline__ void conv_store(const f32x4 (&v)[8], int K, bf16_t* WT, const float* gain, LAS float* scr, int kb, int nb, int lane) {
    const int k0 = 64 * kb, n0 = 32 * nb, kr = lane >> 3, nc = (lane & 7) * 4;
    float g[8];
#pragma unroll
    for (int i = 0; i < 8; ++i) g[i] = gain ? gain[k0 + 8 * i + kr] : 1.f;
#pragma unroll
    for (int i = 0; i < 8; ++i) { const int k = 8 * i + kr; *(LAS f32x4*)(scr + k * 36 + 4 * (k >> 3) + nc) = v[i] * g[i]; }
    LDS_WAIT();
    const int c = lane & 7;
#pragma unroll
    for (int j = 0; j < 4; ++j) { const int n = (lane >> 3) + 8 * j; const LAS float* s = scr + (8 * c) * 36 + 4 * c + n;
        u32x4 o; o.x = pk2(s[0 * 36], s[1 * 36]); o.y = pk2(s[2 * 36], s[3 * 36]); o.z = pk2(s[4 * 36], s[5 * 36]); o.w = pk2(s[6 * 36], s[7 * 36]);
        *(u32x4*)(WT + (size_t)(n0 + n) * K + k0 + 8 * c) = o; }
    LDS_WAIT();
}
__device__ __forceinline__ void convert_w(const float* W, int ldw, int K, int N, bf16_t* WT, const float* gain, LAS float* scr, int gw, int ngw, int lane) {
    const int nblk = N / 32, nitems = (K / 64) * nblk;
    f32x4 v[8], v1[8], v2[8];
#pragma unroll
    for (int i = 0; i < 8; ++i) { v[i] = (f32x4){0.f, 0.f, 0.f, 0.f}; v1[i] = v[i]; v2[i] = v[i]; }
    int it = gw;
    if (it < nitems) conv_load(v, W, ldw, it / nblk, it % nblk, lane);
    if (it + ngw < nitems) conv_load(v1, W, ldw, (it + ngw) / nblk, (it + ngw) % nblk, lane);
    while (it < nitems) { const int n2 = it + 2 * ngw;
        if (n2 < nitems) conv_load(v2, W, ldw, n2 / nblk, n2 % nblk, lane);
        conv_store(v, K, WT, gain, scr, it / nblk, it % nblk, lane);
#pragma unroll
        for (int i = 0; i < 8; ++i) { v[i] = v1[i]; v1[i] = v2[i]; }
        it += ngw; }
}
__device__ __forceinline__ void conv_mix(PP p, int L, LAS float* scr, int gw, int ngw, int lane) {
    bf16_t* wm = (bf16_t*)(p->ws + WS_WMIX); const float* gain = p->in[1] + L * 1024; const int m = L % 3, j = L / 3;
    if (m == 0) { convert_w(p->in[6] + (size_t)j * 1024 * 1536, 1536, 1024, 1536, wm, gain, scr, gw, ngw, lane);
                  convert_w(p->in[9] + (size_t)j * 1024 * 1024, 1024, 1024, 1024, wm + 1536 * 1024, nullptr, scr, gw, ngw, lane); }
    else if (m == 1) { convert_w(p->in[10] + (size_t)j * 1024 * 4096, 4096, 1024, 4096, wm, gain, scr, gw, ngw, lane);
                       convert_w(p->in[13] + (size_t)j * 1024 * 1024, 1024, 1024, 1024, wm + 4096 * 1024, nullptr, scr, gw, ngw, lane); }
    else { const float* w = p->in[14] + (size_t)j * 1024 * 3088;
           convert_w(w, 3088, 1024, 3072, wm, gain, scr, gw, ngw, lane);
           convert_w(p->in[16] + (size_t)j * 1024 * 1024, 1024, 1024, 1024, wm + 3072 * 1024, nullptr, scr, gw, ngw, lane);
           bf16_t* wf = wm + 4096 * 1024;
           for (int idx = gw * 64 + lane; idx < 16 * 1024; idx += ngw * 64) { const int h = idx & 15, k = idx >> 4; wf[h * 1024 + k] = (bf16_t)(pk2(w[(size_t)k * 3088 + 3072 + h] * gain[k], 0.f) & 0xffffu); } }
}
__device__ __forceinline__ void conv_mlp(PP p, int L, LAS float* scr, int gw, int ngw, int lane) {
    bf16_t* wl = (bf16_t*)(p->ws + WS_WMLP);
    convert_w(p->in[4] + (size_t)L * 1024 * 4096, 4096, 1024, 4096, wl, p->in[2] + L * 1024, scr, gw, ngw, lane);
    convert_w(p->in[5] + (size_t)L * 4096 * 1024, 1024, 4096, 1024, wl + 4096 * 1024, nullptr, scr, gw, ngw, lane);
}

template <class Epi, int NC, int KC, int LDA> __device__ __forceinline__ void run_gemm(LAS unsigned char* lds, const bf16_t* A, const bf16_t* Bt, const Epi& E, int tid, int bid, int nblk) {
    pg8::Gemm g{A, Bt, T, NC, KC, LDA}; pg8::StaticOrder S; S.init(T, NC, nblk, bid);
    pg8::gemm_phase<Epi, pg8::StaticOrder, KC, LDA, true, true>(lds, g, S, E, tid);
}
typedef short v4i16_t __attribute__((ext_vector_type(4)));
__device__ __forceinline__ s16x4 vtr(const LAS unsigned char* p) { return __builtin_bit_cast(s16x4, __builtin_amdgcn_ds_read_tr16_b64_v4i16((LAS v4i16_t*)p)); }
struct AttnCfg { bf16_t* buf; int ld, koff, voff, ooff, fox; const float* sinks; const float* c2; const float* pk; const float* seg; };
__device__ __forceinline__ void attn_phase(LAS unsigned char* lds, const AttnCfg c, const int tid, const int bid, const int nblk) {
    constexpr bool FOXC = true;
    const int lane = tid & 63, wid = __builtin_amdgcn_readfirstlane(tid >> 6), r32 = lane & 31, hi = lane >> 5;
    LAS unsigned char* Kl = lds; LAS unsigned char* Vl = lds + 9216; LAS float* c2t = (LAS float*)(lds + 18432); LAS int* flags = (LAS int*)(lds + 18688); LAS float* soff = (LAS float*)(lds + 18816); LAS float* smax = soff + 16; LAS float* bnd = soff + 32;
    const int srow = tid >> 3, sch = tid & 7;
    const float NEG = -INFINITY;
    for (int u = bid; u < 1024; u += nblk) {
        const int h = FOXC ? (u & 15) : 4 * (u & 3) + (wid & 3), qb = FOXC ? (u >> 4) : (u >> 2), kvh = FOXC ? h : (u & 3);
        const int tw = FOXC ? qb * 256 + 32 * wid : qb * 64 + 32 * (wid >> 2), qpos = tw + r32;
        const bf16_t* qp = c.buf + (size_t)qpos * c.ld + h * 64 + 8 * hi;
        bf16x8 qr[4];
#pragma unroll
        for (int d0 = 0; d0 < 4; ++d0) qr[d0] = *(const bf16x8*)(qp + 16 * d0);
        if (FOXC) {
            if (wid == 0) { const float v = (lane < 16) ? c.seg[h * 16 + lane] : 0.f, mv = (lane < 16) ? c.seg[256 + h * 16 + lane] : 0.f; float is = v, im = mv;
#pragma unroll
                for (int o = 1; o < 16; o <<= 1) { const float x = __shfl_up(is, o), y = __shfl_up(im, o); if (lane >= o) { is += x; im = fmaxf(im, y); } }
                float em = __shfl_up(im, 1); if (lane == 0) em = 0.f;
                if (lane < 16) { soff[lane] = is - v; smax[lane] = em; } }
            LBAR(); }
        float qn = 0.f, cq = 0.f;
        if (FOXC) { float ss = 0.f;
#pragma unroll
            for (int d0 = 0; d0 < 4; ++d0)
#pragma unroll
                for (int e = 0; e < 8; ++e) { const float v = __uint_as_float(((unsigned)(unsigned short)qr[d0][e]) << 16); ss += v * v; }
            ss += __shfl_xor(ss, 32); qn = sqrtf(ss) * 1.0001f; cq = c.c2[(size_t)h * T + qpos] + soff[qpos >> 10]; }
        float m = FOXC ? -1e30f : c.sinks[h] * LOG2E, l = FOXC ? 0.f : (hi == 0 ? 1.f : 0.f);
        f32x16 o0, o1;
#pragma unroll
        for (int i = 0; i < 16; ++i) { o0[i] = 0.f; o1[i] = 0.f; }
        const int kt_hi = FOXC ? 4 * qb + 3 : qb, kt_lo = FOXC ? 0 : (qb - 2 > 0 ? qb - 2 : 0);
        const bf16_t* kg = c.buf + c.koff + kvh * 64 + sch * 8; const bf16_t* vg = c.buf + c.voff + kvh * 64 + sch * 8;
        u32x4 kst, vst, kst1 = {0u, 0u, 0u, 0u}, vst1 = {0u, 0u, 0u, 0u}; float cst = 0.f, cst1 = 0.f, pst1 = 0.f;
        { const size_t r = (size_t)(64 * kt_hi + srow) * c.ld; kst = *(const u32x4*)(kg + r); vst = *(const u32x4*)(vg + r); if (FOXC && tid < 64) cst = c.c2[(size_t)h * T + 64 * kt_hi + tid]; }
        if (kt_hi > kt_lo) { const size_t r = (size_t)(64 * (kt_hi - 1) + srow) * c.ld; kst1 = *(const u32x4*)(kg + r); vst1 = *(const u32x4*)(vg + r);
            if (FOXC && tid < 64) { cst1 = c.c2[(size_t)h * T + 64 * (kt_hi - 1) + tid]; if (tid == 63) pst1 = c.pk[(size_t)h * T + 64 * (kt_hi - 1) + 63]; } }
        bool active = true; int par = 0;
        for (int kt = kt_hi;; --kt) {
            *(LAS u32x4*)(Kl + srow * 144 + sch * 16) = kst;
            *(LAS u32x4*)(Vl + srow * 144 + sch * 16) = vst;
            if (FOXC && tid < 64) { c2t[tid] = cst; if (tid == 63) { bnd[0] = cst1; bnd[1] = pst1; } }
            LBAR();
            kst = kst1; vst = vst1; cst = cst1;
            float pkn = 0.f, c2n = 0.f;
            if (FOXC && kt > 0) { const int sp = 64 * kt - 1; pkn = fmaxf(bnd[1], smax[sp >> 10]); c2n = bnd[0] + soff[sp >> 10]; }
            if (kt - 2 >= kt_lo) { const size_t r = (size_t)(64 * (kt - 2) + srow) * c.ld; kst1 = *(const u32x4*)(kg + r); vst1 = *(const u32x4*)(vg + r);
                if (FOXC && tid < 64) { cst1 = c.c2[(size_t)h * T + 64 * (kt - 2) + tid]; if (tid == 63) pst1 = c.pk[(size_t)h * T + 64 * (kt - 2) + 63]; } }
            const bool causal_skip = 64 * kt > tw + 31;
            bool rel = active && !causal_skip; if (!FOXC) rel = rel && (64 * kt + 63 >= tw - 127);
            if (rel) {
                f32x16 p0, p1;
#pragma unroll
                for (int i = 0; i < 16; ++i) { p0[i] = 0.f; p1[i] = 0.f; }
#pragma unroll
                for (int d0 = 0; d0 < 4; ++d0) { const bf16x8 a0 = *(const LAS bf16x8*)(Kl + r32 * 144 + d0 * 32 + hi * 16), a1 = *(const LAS bf16x8*)(Kl + (32 + r32) * 144 + d0 * 32 + hi * 16);
                    p0 = MFMA32(a0, qr[d0], p0); p1 = MFMA32(a1, qr[d0], p1); }
                const bool full = (64 * kt + 63 <= tw) && (FOXC || (tw + 31 - 64 * kt < 128));
                const float cqt = FOXC ? cq - soff[kt >> 4] : 0.f;
                float rm = NEG;
                f32x4 cA[4], cB[4];
                if (FOXC) {
#pragma unroll
                    for (int g = 0; g < 4; ++g) { cA[g] = *(const LAS f32x4*)(c2t + 8 * g + 4 * hi); cB[g] = *(const LAS f32x4*)(c2t + 32 + 8 * g + 4 * hi); } }
#pragma unroll
                for (int i = 0; i < 16; ++i) { const int kvl = (i & 3) + 8 * (i >> 2) + 4 * hi; float s0 = p0[i], s1 = p1[i];
                    if (FOXC) { s0 += cqt - cA[i >> 2][i & 3]; s1 += cqt - cB[i >> 2][i & 3]; }
                    if (!full) { const int kv0 = 64 * kt + kvl, kv1 = kv0 + 32; bool v0 = kv0 <= qpos, v1 = kv1 <= qpos;
                        if (!FOXC) { v0 = v0 && (qpos - kv0 < 128); v1 = v1 && (qpos - kv1 < 128); }
                        s0 = v0 ? s0 : NEG; s1 = v1 ? s1 : NEG; }
                    p0[i] = s0; p1[i] = s1; rm = fmaxf(rm, fmaxf(s0, s1)); }
                rm = fmaxf(rm, __shfl_xor(rm, 32));
                float mn = m; if (__any((rm > m + 8.f) ? 1 : 0)) mn = fmaxf(m, rm);
                const float alpha = __builtin_amdgcn_exp2f(m - mn); m = mn;
                float ls = 0.f;
#pragma unroll
                for (int i = 0; i < 16; ++i) { p0[i] = __builtin_amdgcn_exp2f(p0[i] - mn); p1[i] = __builtin_amdgcn_exp2f(p1[i] - mn); ls += p0[i] + p1[i]; }
                l = l * alpha + ls;
                if (__any(alpha != 1.f ? 1 : 0)) {
#pragma unroll
                    for (int i = 0; i < 16; ++i) { o0[i] *= alpha; o1[i] *= alpha; } }
#pragma unroll
                for (int sp = 0; sp < 4; ++sp) { const int blk = sp >> 1, s = sp & 1; u32x4 pw;
                    if (blk == 0) { pw.x = pk2(p0[8 * s], p0[8 * s + 1]); pw.y = pk2(p0[8 * s + 2], p0[8 * s + 3]); pw.z = pk2(p0[8 * s + 4], p0[8 * s + 5]); pw.w = pk2(p0[8 * s + 6], p0[8 * s + 7]); }
                    else { pw.x = pk2(p1[8 * s], p1[8 * s + 1]); pw.y = pk2(p1[8 * s + 2], p1[8 * s + 3]); pw.z = pk2(p1[8 * s + 4], p1[8 * s + 5]); pw.w = pk2(p1[8 * s + 6], p1[8 * s + 7]); }
                    const bf16x8 pf = __builtin_bit_cast(bf16x8, pw);
                    { const LAS unsigned char* vp = Vl + (32 * blk + 16 * s + 4 * hi + ((lane & 15) >> 2)) * 144 + (16 * ((lane >> 4) & 1) + 4 * (lane & 3)) * 2;
                      const bf16x8 vf0 = __builtin_shufflevector(vtr(vp), vtr(vp + 8 * 144), 0, 1, 2, 3, 4, 5, 6, 7); o0 = MFMA32(vf0, pf, o0);
                      const bf16x8 vf1 = __builtin_shufflevector(vtr(vp + 64), vtr(vp + 64 + 8 * 144), 0, 1, 2, 3, 4, 5, 6, 7); o1 = MFMA32(vf1, pf, o1); } }
            }
            bool need;
            if (FOXC) { need = causal_skip ? true : (active && kt > 0 && __any((qn * pkn + cq - c2n - m > -40.f) ? 1 : 0) != 0); if (!causal_skip) active = need; }
            else need = (64 * kt - 1 >= tw - 127);
            if (lane == 0) flags[par * 8 + wid] = need ? 1 : 0;
            LBAR();
            if (kt == kt_lo) break;
            int any = 0;
#pragma unroll
            for (int w = 0; w < 8; ++w) any |= flags[par * 8 + w];
            par ^= 1;
            if (!any) break;
        }
        const float lt = l + __shfl_xor(l, 32), inv = 1.f / lt;
        bf16_t* ob = c.buf + (size_t)qpos * c.ld + c.ooff + h * 64;
#pragma unroll
        for (int gp = 0; gp < 4; gp += 2) {
            u32x2 a0, b0, a1, b1;
            a0.x = pk2(o0[4 * gp] * inv, o0[4 * gp + 1] * inv); a0.y = pk2(o0[4 * gp + 2] * inv, o0[4 * gp + 3] * inv);
            b0.x = pk2(o0[4 * gp + 4] * inv, o0[4 * gp + 5] * inv); b0.y = pk2(o0[4 * gp + 6] * inv, o0[4 * gp + 7] * inv);
            a1.x = pk2(o1[4 * gp] * inv, o1[4 * gp + 1] * inv); a1.y = pk2(o1[4 * gp + 2] * inv, o1[4 * gp + 3] * inv);
            b1.x = pk2(o1[4 * gp + 4] * inv, o1[4 * gp + 5] * inv); b1.y = pk2(o1[4 * gp + 6] * inv, o1[4 * gp + 7] * inv);
            { auto r = __builtin_amdgcn_permlane32_swap(a0.x, b0.x, false, false); a0.x = r[0]; b0.x = r[1]; }
            { auto r = __builtin_amdgcn_permlane32_swap(a0.y, b0.y, false, false); a0.y = r[0]; b0.y = r[1]; }
            { auto r = __builtin_amdgcn_permlane32_swap(a1.x, b1.x, false, false); a1.x = r[0]; b1.x = r[1]; }
            { auto r = __builtin_amdgcn_permlane32_swap(a1.y, b1.y, false, false); a1.y = r[0]; b1.y = r[1]; }
            u32x4 s0; s0.x = a0.x; s0.y = a0.y; s0.z = b0.x; s0.w = b0.y; u32x4 s1; s1.x = a1.x; s1.y = a1.y; s1.z = b1.x; s1.w = b1.y;
            *(u32x4*)(ob + 8 * gp + 8 * hi) = s0; *(u32x4*)(ob + 32 + 8 * gp + 8 * hi) = s1; }
    }
}

__device__ __forceinline__ void swa_unit(int u, int nblk, int& kvh, int& qb) {
    if (nblk == 256) { const int it = u >> 8, b = u & 255, x = b & 7, j = it * 32 + (b >> 3); qb = 32 * x + (j >> 2); kvh = j & 3; }
    else { kvh = u & 3; qb = u >> 2; }
}
__device__ __forceinline__ void swa_phase(LAS unsigned char* lds, bf16_t* buf, const float* sinks, const int tid, const int bid, const int nblk) {
    const int lane = tid & 63, wid = __builtin_amdgcn_readfirstlane(tid >> 6), r32 = lane & 31, hi = lane >> 5;
    const int srow = tid >> 3, sch = tid & 7; const float NEG = -INFINITY;
    constexpr int LD = 4096, KOFF = 1024, VOFF = 1280, OOFF = 2048;
    u32x4 kp[3], vp[3];
#pragma unroll
    for (int j = 0; j < 3; ++j) { kp[j] = (u32x4){0u, 0u, 0u, 0u}; vp[j] = kp[j]; }
    bf16x8 qnx[4];
#pragma unroll
    for (int d0 = 0; d0 < 4; ++d0) qnx[d0] = (bf16x8){0, 0, 0, 0, 0, 0, 0, 0};
    if (bid < 1024) { int kvh, qb; swa_unit(bid, nblk, kvh, qb);
      { const bf16_t* qp0 = buf + (size_t)(64 * qb + 32 * (wid >> 2) + r32) * LD + (4 * kvh + (wid & 3)) * 64 + 8 * hi;
#pragma unroll
        for (int d0 = 0; d0 < 4; ++d0) qnx[d0] = *(const bf16x8*)(qp0 + 16 * d0); }
#pragma unroll
        for (int j = 0; j < 3; ++j) { const int kt = qb - 2 + j; if (kt >= 0) { const bf16_t* r = buf + (size_t)(64 * kt + srow) * LD + kvh * 64 + sch * 8; kp[j] = *(const u32x4*)(r + KOFF); vp[j] = *(const u32x4*)(r + VOFF); } } }
    int par = 0;
    for (int u = bid; u < 1024; u += nblk) {
        LAS unsigned char* lb = lds + par * 55296;
        int kvh, qb; swa_unit(u, nblk, kvh, qb);
        const int h = 4 * kvh + (wid & 3), tw = 64 * qb + 32 * (wid >> 2), qpos = tw + r32;
#pragma unroll
        for (int j = 0; j < 3; ++j) { *(LAS u32x4*)(lb + j * 9216 + srow * 144 + sch * 16) = kp[j]; *(LAS u32x4*)(lb + 27648 + j * 9216 + srow * 144 + sch * 16) = vp[j]; }
        LBAR();
        { const int un = u + nblk; if (un < 1024) { int kvn, qn_; swa_unit(un, nblk, kvn, qn_);
#pragma unroll
            for (int j = 0; j < 3; ++j) { const int kt = qn_ - 2 + j; if (kt >= 0) { const bf16_t* r = buf + (size_t)(64 * kt + srow) * LD + kvn * 64 + sch * 8; kp[j] = *(const u32x4*)(r + KOFF); vp[j] = *(const u32x4*)(r + VOFF); } } } }
        bf16x8 qr[4];
#pragma unroll
        for (int d0 = 0; d0 < 4; ++d0) qr[d0] = qnx[d0];
        { const int un = u + nblk; if (un < 1024) { int kvq, qbq; swa_unit(un, nblk, kvq, qbq); const bf16_t* qpn = buf + (size_t)(64 * qbq + 32 * (wid >> 2) + r32) * LD + (4 * kvq + (wid & 3)) * 64 + 8 * hi;
#pragma unroll
            for (int d0 = 0; d0 < 4; ++d0) qnx[d0] = *(const bf16x8*)(qpn + 16 * d0); } }
        float m = sinks[h] * LOG2E, l = (hi == 0) ? 1.f : 0.f;
        f32x16 o0, o1;
#pragma unroll
        for (int i = 0; i < 16; ++i) { o0[i] = 0.f; o1[i] = 0.f; }
#pragma unroll
        for (int j = 2; j >= 0; --j) { const int kt = qb - 2 + j;
            if (kt >= 0 && 64 * kt + 63 >= tw - 127) {
                const LAS unsigned char* Kl = lb + j * 9216; const LAS unsigned char* Vl = lb + 27648 + j * 9216;
                f32x16 p0, p1;
#pragma unroll
                for (int i = 0; i < 16; ++i) { p0[i] = 0.f; p1[i] = 0.f; }
#pragma unroll
                for (int d0 = 0; d0 < 4; ++d0) { const bf16x8 a0 = *(const LAS bf16x8*)(Kl + r32 * 144 + d0 * 32 + hi * 16), a1 = *(const LAS bf16x8*)(Kl + (32 + r32) * 144 + d0 * 32 + hi * 16);
                    p0 = MFMA32(a0, qr[d0], p0); p1 = MFMA32(a1, qr[d0], p1); }
                const bool full = (64 * kt + 63 <= tw) && (tw + 31 - 64 * kt < 128);
                float rm = NEG;
                if (!full) {
                    const int dq = qpos - 64 * kt - 4 * hi;
#pragma unroll
                    for (int i = 0; i < 16; ++i) { const unsigned d0 = (unsigned)(dq - ((i & 3) + 8 * (i >> 2))), d1 = d0 - 32u;
                        p0[i] = (d0 < 128u) ? p0[i] : NEG; p1[i] = (d1 < 128u) ? p1[i] : NEG; } }
#pragma unroll
                for (int i = 0; i < 16; ++i) rm = fmaxf(rm, fmaxf(p0[i], p1[i]));
                rm = fmaxf(rm, __shfl_xor(rm, 32));
                float mn = m; if (__any((rm > m + 8.f) ? 1 : 0)) mn = fmaxf(m, rm);
                const float alpha = __builtin_amdgcn_exp2f(m - mn); m = mn;
                float ls = 0.f;
#pragma unroll
                for (int i = 0; i < 16; ++i) { p0[i] = __builtin_amdgcn_exp2f(p0[i] - mn); p1[i] = __builtin_amdgcn_exp2f(p1[i] - mn); ls += p0[i] + p1[i]; }
                l = l * alpha + ls;
                if (__any(alpha != 1.f ? 1 : 0)) {
#pragma unroll
                    for (int i = 0; i < 16; ++i) { o0[i] *= alpha; o1[i] *= alpha; } }
#pragma unroll
                for (int sp = 0; sp < 4; ++sp) { const int blk = sp >> 1, s = sp & 1; u32x4 pw;
                    if (blk == 0) { pw.x = pk2(p0[8 * s], p0[8 * s + 1]); pw.y = pk2(p0[8 * s + 2], p0[8 * s + 3]); pw.z = pk2(p0[8 * s + 4], p0[8 * s + 5]); pw.w = pk2(p0[8 * s + 6], p0[8 * s + 7]); }
                    else { pw.x = pk2(p1[8 * s], p1[8 * s + 1]); pw.y = pk2(p1[8 * s + 2], p1[8 * s + 3]); pw.z = pk2(p1[8 * s + 4], p1[8 * s + 5]); pw.w = pk2(p1[8 * s + 6], p1[8 * s + 7]); }
                    const bf16x8 pf = __builtin_bit_cast(bf16x8, pw);
                    const LAS unsigned char* vq = Vl + (32 * blk + 16 * s + 4 * hi + ((lane & 15) >> 2)) * 144 + (16 * ((lane >> 4) & 1) + 4 * (lane & 3)) * 2;
                    const bf16x8 vf0 = __builtin_shufflevector(vtr(vq), vtr(vq + 8 * 144), 0, 1, 2, 3, 4, 5, 6, 7); o0 = MFMA32(vf0, pf, o0);
                    const bf16x8 vf1 = __builtin_shufflevector(vtr(vq + 64), vtr(vq + 64 + 8 * 144), 0, 1, 2, 3, 4, 5, 6, 7); o1 = MFMA32(vf1, pf, o1); }
            } }
        const float lt = l + __shfl_xor(l, 32), inv = 1.f / lt;
        bf16_t* ob = buf + (size_t)qpos * LD + OOFF + h * 64;
#pragma unroll
        for (int gp = 0; gp < 4; gp += 2) {
            u32x2 a0, b0, a1, b1;
            a0.x = pk2(o0[4 * gp] * inv, o0[4 * gp + 1] * inv); a0.y = pk2(o0[4 * gp + 2] * inv, o0[4 * gp + 3] * inv);
            b0.x = pk2(o0[4 * gp + 4] * inv, o0[4 * gp + 5] * inv); b0.y = pk2(o0[4 * gp + 6] * inv, o0[4 * gp + 7] * inv);
            a1.x = pk2(o1[4 * gp] * inv, o1[4 * gp + 1] * inv); a1.y = pk2(o1[4 * gp + 2] * inv, o1[4 * gp + 3] * inv);
            b1.x = pk2(o1[4 * gp + 4] * inv, o1[4 * gp + 5] * inv); b1.y = pk2(o1[4 * gp + 6] * inv, o1[4 * gp + 7] * inv);
            { auto r = __builtin_amdgcn_permlane32_swap(a0.x, b0.x, false, false); a0.x = r[0]; b0.x = r[1]; }
            { auto r = __builtin_amdgcn_permlane32_swap(a0.y, b0.y, false, false); a0.y = r[0]; b0.y = r[1]; }
            { auto r = __builtin_amdgcn_permlane32_swap(a1.x, b1.x, false, false); a1.x = r[0]; b1.x = r[1]; }
            { auto r = __builtin_amdgcn_permlane32_swap(a1.y, b1.y, false, false); a1.y = r[0]; b1.y = r[1]; }
            u32x4 s0; s0.x = a0.x; s0.y = a0.y; s0.z = b0.x; s0.w = b0.y; u32x4 s1; s1.x = a1.x; s1.y = a1.y; s1.z = b1.x; s1.w = b1.y;
            *(u32x4*)(ob + 8 * gp + 8 * hi) = s0; *(u32x4*)(ob + 32 + 8 * gp + 8 * hi) = s1; }
        par ^= 1;
    }
}

__device__ __forceinline__ void fox_flog(PP p, const float* ssq, const float* bias, int gw, int ngw, int lane) {
    const bf16_t* XB = (const bf16_t*)(p->ws + WS_XB); const bf16_t* WF = (const bf16_t*)(p->ws + WS_WMIX) + 4096 * 1024; float* LF = (float*)(p->ws + WS_LF);
    const int fr = lane & 15, q = lane >> 4;
    for (int tl = gw; tl < T / 16; tl += ngw) { const int t0 = 16 * tl; f32x4 acc = {0.f, 0.f, 0.f, 0.f};
        const bf16_t* ap = XB + (size_t)(t0 + fr) * 1024 + 8 * q; const bf16_t* bp = WF + (size_t)fr * 1024 + 8 * q;
#pragma unroll 8
        for (int ks = 0; ks < 32; ++ks) acc = MFMA16(*(const bf16x8*)(ap + 32 * ks), *(const bf16x8*)(bp + 32 * ks), acc);
        const float bb = bias[fr];
#pragma unroll
        for (int j = 0; j < 4; ++j) { const int t = t0 + 4 * q + j; const float rs = row_rstd(ssq, t); const float v = acc[j] * rs + bb;
            const float ls = (v < 0.f) ? (v - log1pf(__expf(v))) : -log1pf(__expf(-v)); LF[(size_t)t * 16 + fr] = ls * LOG2E; } }
}
__device__ __forceinline__ void fox_scan(LAS unsigned char* lds, PP p, const int tid, const int bid, const int nblk) {
    const int lane = tid & 63, wid = tid >> 6;
    const float* LF = (const float*)(p->ws + WS_LF); float* C2 = (float*)(p->ws + WS_C2); float* PK = (float*)(p->ws + WS_PK); float* SEG = (float*)(p->ws + WS_SEG);
    LAS float* ws_sum = (LAS float*)lds; LAS float* ws_max = ws_sum + 8;
    for (int u = bid; u < 256; u += nblk) { const int h = u & 15, sg = u >> 4, t0 = sg * 1024 + 2 * tid;
        const bf16_t* KB = (const bf16_t*)(p->ws + WS_BIG) + 1024 + h * 64 + (size_t)t0 * 4096;
        u32x4 ka[8], kb[8];
#pragma unroll
        for (int c = 0; c < 8; ++c) { ka[c] = *(const u32x4*)(KB + 8 * c); kb[c] = *(const u32x4*)(KB + 4096 + 8 * c); }
        const float l0 = LF[(size_t)t0 * 16 + h], l1 = LF[(size_t)(t0 + 1) * 16 + h];
        float n0 = 0.f, n1 = 0.f;
#pragma unroll
        for (int c = 0; c < 8; ++c)
#pragma unroll
            for (int e = 0; e < 8; ++e) { const float f0 = bf_get(ka[c], e), f1 = bf_get(kb[c], e); n0 += f0 * f0; n1 += f1 * f1; }
        const float s = l0 + l1, mx = fmaxf(n0, n1);
        float is = s, im = mx;
#pragma unroll
        for (int o = 1; o < 64; o <<= 1) { const float a = __shfl_up(is, o), b = __shfl_up(im, o); if (lane >= o) { is += a; im = fmaxf(im, b); } }
        if (lane == 63) { ws_sum[wid] = is; ws_max[wid] = im; }
        __syncthreads();
        float es = is - s, em = __shfl_up(im, 1); if (lane == 0) em = 0.f;
        for (int w = 0; w < wid; ++w) { es += ws_sum[w]; em = fmaxf(em, ws_max[w]); }
        const float m0 = fmaxf(em, n0), m1 = fmaxf(m0, n1);
        C2[(size_t)h * T + t0] = es + l0; C2[(size_t)h * T + t0 + 1] = (es + l0) + l1;
        PK[(size_t)h * T + t0] = sqrtf(m0) * 1.0001f; PK[(size_t)h * T + t0 + 1] = sqrtf(m1) * 1.0001f;
        if (tid == NTHR - 1) { SEG[h * 16 + sg] = (es + l0) + l1; SEG[256 + h * 16 + sg] = sqrtf(m1) * 1.0001f; }
        __syncthreads();
    }
}
__device__ __forceinline__ void hgrn_x1(LAS unsigned char* lds, PP p, int layer, const int tid, const int bid, const int nblk) {
    bf16_t* PB = (bf16_t*)(p->ws + WS_BIG); float* DS = (float*)(p->ws + WS_DS); float* DSEG = (float*)(p->ws + WS_DSEG); const float* lbl = p->in[11];
    LAS float* LF = (LAS float*)lds;
    LAS float* GT = (LAS float*)(lds + 16896);
    LAS float* BP = (LAS float*)(lds + 18944);
    LAS float* ED = (LAS float*)(lds + 19456);
    LAS float* LB = (LAS float*)(lds + 19968);
    LAS unsigned char* QT = lds + 20480;
    LAS unsigned char* KT = lds + 29184;
    LAS unsigned char* KH = lds + 37888;
    LAS unsigned char* VT = lds + 46592;
    const int lane = tid & 63, wid = __builtin_amdgcn_readfirstlane(tid >> 6), fr = lane & 15, q = lane >> 4;
    const int pt = tid >> 4, kg = tid & 15, ck = tid & 127, ctg = tid >> 7;
    for (int u = bid; u < 256; u += nblk) {
        const int h = u >> 5, sg = u & 31, row0 = sg * 512;
        if (tid < 128) { const int kk = h * 128 + tid; const float a0 = lbl[kk], a1 = lbl[1024 + kk], a2 = lbl[2048 + kk], a3 = lbl[3072 + kk];
            const float mx = fmaxf(fmaxf(a0, a1), fmaxf(a2, a3)); const float e0 = __expf(a0 - mx), e1 = __expf(a1 - mx), e2 = __expf(a2 - mx), e3 = __expf(a3 - mx);
            float lbv = 0.f; if (layer >= 1) lbv += e1; if (layer >= 2) lbv += e2; if (layer >= 3) lbv += e3;
            LB[tid] = lbv / (e0 + e1 + e2 + e3); BP[tid] = 0.f; }
        f32x4 S[8];
#pragma unroll
        for (int i = 0; i < 8; ++i) S[i] = (f32x4){0.f, 0.f, 0.f, 0.f};
        u32x4 nq, nz, nv;
        { const bf16_t* nb = PB + (size_t)(row0 + pt) * 4096 + h * 128 + 8 * kg; nq = *(const u32x4*)nb; nz = *(const u32x4*)(nb + 1024); nv = *(const u32x4*)(nb + 2048); }
        __syncthreads();
        for (int c = 0; c < 16; ++c) {
            const int crow0 = row0 + 32 * c;
            bf16_t* base = PB + (size_t)(crow0 + pt) * 4096 + h * 128 + 8 * kg;
            const u32x4 qv = nq, zv = nz, vv = nv;
            if (c + 1 < 16) { const bf16_t* nb = base + (size_t)32 * 4096; nq = *(const u32x4*)nb; nz = *(const u32x4*)(nb + 1024); nv = *(const u32x4*)(nb + 2048); }
            float fk[8], qs[8], blast[8];
            const f32x4 lbA = *(const LAS f32x4*)(LB + 8 * kg), lbB = *(const LAS f32x4*)(LB + 8 * kg + 4);
#pragma unroll
            for (int i = 0; i < 8; ++i) { const float z = bf_get(zv, i), lb = (i < 4) ? lbA[i & 3] : lbB[i & 3]; const float sgm = 1.f / (1.f + __expf(-z)); const float f = lb + (1.f - lb) * sgm;
                LF[pt * 132 + 8 * kg + i] = __logf(f); fk[i] = 1.f - f; qs[i] = bf_get(qv, i); }
            LBAR();
            { float run = 0.f;
#pragma unroll
              for (int tt = 0; tt < 8; ++tt) { const int a = (8 * ctg + tt) * 132 + ck; run += LF[a]; LF[a] = run; }
              GT[ctg * 128 + ck] = run; }
            LBAR();
            { const int tgp = pt >> 3; float qt[8], ktv[8], qg[8], khv[8];
              f32x4 gA[4], gB[4];
#pragma unroll
              for (int g = 0; g < 4; ++g) { gA[g] = *(const LAS f32x4*)(GT + g * 128 + 8 * kg); gB[g] = *(const LAS f32x4*)(GT + g * 128 + 8 * kg + 4); }
              const f32x4 lfA = *(const LAS f32x4*)(LF + pt * 132 + 8 * kg), lfB = *(const LAS f32x4*)(LF + pt * 132 + 8 * kg + 4);
              const f32x4 bpA = *(const LAS f32x4*)(BP + 8 * kg), bpB = *(const LAS f32x4*)(BP + 8 * kg + 4);
#pragma unroll
              for (int i = 0; i < 8; ++i) { const int k = 8 * kg + i; const int e = i & 3;
                  const float g0 = (i < 4) ? gA[0][e] : gB[0][e], g1 = (i < 4) ? gA[1][e] : gB[1][e], g2 = (i < 4) ? gA[2][e] : gB[2][e], g3 = (i < 4) ? gA[3][e] : gB[3][e];
                  const float pre = (tgp > 0 ? g0 : 0.f) + (tgp > 1 ? g1 : 0.f) + (tgp > 2 ? g2 : 0.f); const float bl = (g0 + g1) + (g2 + g3);
                  const float b = ((i < 4) ? lfA[e] : lfB[e]) + pre; const float Bp = (i < 4) ? bpA[e] : bpB[e];
                  qt[i] = qs[i] * __expf(b); ktv[i] = fk[i] * __expf(fminf(-b, 80.f)); khv[i] = fk[i] * __expf(bl - b); qg[i] = qs[i] * __expf(Bp + b);
                  blast[i] = bl; if (pt == 31) ED[k] = __expf(bl); }
              u32x4 w; w.x = pk2(qt[0], qt[1]); w.y = pk2(qt[2], qt[3]); w.z = pk2(qt[4], qt[5]); w.w = pk2(qt[6], qt[7]); *(LAS u32x4*)(QT + pt * 272 + kg * 16) = w;
              w.x = pk2(ktv[0], ktv[1]); w.y = pk2(ktv[2], ktv[3]); w.z = pk2(ktv[4], ktv[5]); w.w = pk2(ktv[6], ktv[7]); *(LAS u32x4*)(KT + pt * 272 + kg * 16) = w;
              w.x = pk2(khv[0], khv[1]); w.y = pk2(khv[2], khv[3]); w.z = pk2(khv[4], khv[5]); w.w = pk2(khv[6], khv[7]); *(LAS u32x4*)(KH + pt * 272 + kg * 16) = w;
              *(LAS u32x4*)(VT + pt * 272 + kg * 16) = vv;
              w.x = pk2(qg[0], qg[1]); w.y = pk2(qg[2], qg[3]); w.z = pk2(qg[4], qg[5]); w.w = pk2(qg[6], qg[7]); *(u32x4*)base = w; }
            LBAR();
            if (pt == 31) {
#pragma unroll
                for (int i = 0; i < 8; ++i) BP[8 * kg + i] += blast[i]; }
            { f32x4 AT00 = {0.f, 0.f, 0.f, 0.f}, AT01 = AT00, AT11 = AT00;
#pragma unroll
              for (int ks = 0; ks < 4; ++ks) { const bf16x8 a0 = *(const LAS bf16x8*)(KT + fr * 272 + ks * 64 + q * 16), a1 = *(const LAS bf16x8*)(KT + (16 + fr) * 272 + ks * 64 + q * 16);
                  const bf16x8 b0 = *(const LAS bf16x8*)(QT + fr * 272 + ks * 64 + q * 16), b1 = *(const LAS bf16x8*)(QT + (16 + fr) * 272 + ks * 64 + q * 16);
                  AT00 = MFMA16(a0, b0, AT00); AT01 = MFMA16(a0, b1, AT01); AT11 = MFMA16(a1, b1, AT11); }
#pragma unroll
              for (int j = 0; j < 4; ++j) if (4 * q + j > fr) { AT00[j] = 0.f; AT11[j] = 0.f; }
              u32x4 w0, w1; w0.x = pk2(AT00[0], AT00[1]); w0.y = pk2(AT00[2], AT00[3]); w0.z = 0u; w0.w = 0u;
              w1.x = pk2(AT01[0], AT01[1]); w1.y = pk2(AT01[2], AT01[3]); w1.z = pk2(AT11[0], AT11[1]); w1.w = pk2(AT11[2], AT11[3]);
              const bf16x8 Bp0 = __builtin_bit_cast(bf16x8, w0), Bp1 = __builtin_bit_cast(bf16x8, w1);
              const LAS unsigned char* vcol = VT + (fr >> 2) * 272 + (16 * wid + 4 * (fr & 3)) * 2;
              const bf16x8 va = __builtin_shufflevector(vtr(vcol + (4 * q) * 272), vtr(vcol + (16 + 4 * q) * 272), 0, 1, 2, 3, 4, 5, 6, 7);
              const f32x4 zero4 = {0.f, 0.f, 0.f, 0.f};
              f32x4 oT0 = MFMA16(va, Bp0, zero4), oT1 = MFMA16(va, Bp1, zero4);
#pragma unroll
              for (int kk = 0; kk < 4; ++kk) { u32x4 sw; sw.x = pk2(S[2 * kk][0], S[2 * kk][1]); sw.y = pk2(S[2 * kk][2], S[2 * kk][3]); sw.z = pk2(S[2 * kk + 1][0], S[2 * kk + 1][1]); sw.w = pk2(S[2 * kk + 1][2], S[2 * kk + 1][3]);
                  const bf16x8 sa = __builtin_bit_cast(bf16x8, sw);
                  const LAS unsigned char* q0p = QT + fr * 272 + kk * 64 + q * 8; const LAS unsigned char* q1p = q0p + 16 * 272;
                  const bf16x8 qb0 = __builtin_shufflevector(*(const LAS s16x4*)q0p, *(const LAS s16x4*)(q0p + 32), 0, 1, 2, 3, 4, 5, 6, 7);
                  const bf16x8 qb1 = __builtin_shufflevector(*(const LAS s16x4*)q1p, *(const LAS s16x4*)(q1p + 32), 0, 1, 2, 3, 4, 5, 6, 7);
                  oT0 = MFMA16(sa, qb0, oT0); oT1 = MFMA16(sa, qb1, oT1); }
              { bf16_t* op = PB + (size_t)(crow0 + fr) * 4096 + 1024 + h * 128 + 16 * wid + 4 * q; u32x2 w; w.x = pk2(oT0[0], oT0[1]); w.y = pk2(oT0[2], oT0[3]); *(u32x2*)op = w;
                w.x = pk2(oT1[0], oT1[1]); w.y = pk2(oT1[2], oT1[3]); *(u32x2*)(op + (size_t)16 * 4096) = w; }
              const bf16x8 vb = __builtin_shufflevector(vtr(vcol + (8 * q) * 272), vtr(vcol + (8 * q + 4) * 272), 0, 1, 2, 3, 4, 5, 6, 7);
#pragma unroll
              for (int kt = 0; kt < 8; ++kt) { const LAS unsigned char* kc = KH + (8 * q + (fr >> 2)) * 272 + (16 * kt + 4 * (fr & 3)) * 2;
                  const bf16x8 ka = __builtin_shufflevector(vtr(kc), vtr(kc + 4 * 272), 0, 1, 2, 3, 4, 5, 6, 7); const f32x4 ed = *(const LAS f32x4*)(ED + 16 * kt + 4 * q);
                  S[kt] = MFMA16(ka, vb, S[kt] * ed); } }
        }
#pragma unroll
        for (int kt = 0; kt < 8; ++kt)
#pragma unroll
            for (int j = 0; j < 4; ++j) DS[((size_t)u * 128 + 16 * kt + 4 * q + j) * 128 + 16 * wid + fr] = S[kt][j];
        __syncthreads();
        if (tid < 128) DSEG[u * 128 + tid] = __expf(BP[tid]);
        __syncthreads();
    }
}
__device__ __forceinline__ void hgrn_x3(LAS unsigned char* lds, PP p, const float* gnorm, const int tid, const int bid, const int nblk) {
    bf16_t* PB = (bf16_t*)(p->ws + WS_BIG); const float* DS = (const float*)(p->ws + WS_DS); const float* DSEG = (const float*)(p->ws + WS_DSEG);
    LAS unsigned char* ST = lds;
    const int lane = tid & 63, wid = __builtin_amdgcn_readfirstlane(tid >> 6), fr = lane & 15, q = lane >> 4;
    for (int u = bid; u < 256; u += nblk) {
        const int h = u >> 5, sg = u & 31, row0 = sg * 512;
        { const int k = tid & 127, vg = tid >> 7; float acc[32];
#pragma unroll
          for (int i = 0; i < 32; ++i) acc[i] = 0.f;
          float P = 1.f;
          for (int j = sg - 1; j >= 0; --j) { const f32x4* src = (const f32x4*)(DS + ((size_t)((h * 32 + j) * 128 + k)) * 128 + 32 * vg);
#pragma unroll
              for (int i = 0; i < 8; ++i) { const f32x4 v = src[i]; acc[4 * i] += P * v[0]; acc[4 * i + 1] += P * v[1]; acc[4 * i + 2] += P * v[2]; acc[4 * i + 3] += P * v[3]; }
              P *= DSEG[(h * 32 + j) * 128 + k];
              if (!__syncthreads_or(P != 0.f ? 1 : 0)) break; }
#pragma unroll
          for (int i = 0; i < 32; ++i) *(LAS bf16_t*)(ST + (32 * vg + i) * 272 + k * 2) = (bf16_t)(pk2(acc[i], 0.f) & 0xffffu); }
        __syncthreads();
        bf16x8 bqn[4]; u32x4 oln[4], gvn[4];
        { const bf16_t* rp = PB + (size_t)(row0 + 64 * wid + fr) * 4096 + h * 128;
#pragma unroll
          for (int kk = 0; kk < 4; ++kk) bqn[kk] = *(const bf16x8*)(rp + 32 * kk + 8 * q);
#pragma unroll
          for (int pp = 0; pp < 4; ++pp) { oln[pp] = *(const u32x4*)(rp + 1024 + 32 * pp + 8 * q); gvn[pp] = *(const u32x4*)(rp + 3072 + 32 * pp + 8 * q); } }
#pragma unroll
        for (int tb = 0; tb < 4; ++tb) { const int t = row0 + 64 * wid + 16 * tb + fr; bf16_t* rowp = PB + (size_t)t * 4096 + h * 128;
            bf16x8 bq[4]; u32x4 olv[4], gvv[4];
#pragma unroll
            for (int kk = 0; kk < 4; ++kk) bq[kk] = bqn[kk];
#pragma unroll
            for (int pp = 0; pp < 4; ++pp) { olv[pp] = oln[pp]; gvv[pp] = gvn[pp]; }
            if (tb < 3) { const bf16_t* rp = rowp + (size_t)16 * 4096;
#pragma unroll
                for (int kk = 0; kk < 4; ++kk) bqn[kk] = *(const bf16x8*)(rp + 32 * kk + 8 * q);
#pragma unroll
                for (int pp = 0; pp < 4; ++pp) { oln[pp] = *(const u32x4*)(rp + 1024 + 32 * pp + 8 * q); gvn[pp] = *(const u32x4*)(rp + 3072 + 32 * pp + 8 * q); } }
            f32x4 oT[8];
#pragma unroll
            for (int vt = 0; vt < 8; ++vt) oT[vt] = (f32x4){0.f, 0.f, 0.f, 0.f};
            if (sg > 0) {
#pragma unroll
                for (int kk = 0; kk < 4; ++kk) {
#pragma unroll
                    for (int vt = 0; vt < 8; ++vt) { const int vrow = 32 * (vt >> 1) + 8 * (fr >> 2) + 4 * (vt & 1) + (fr & 3);
                        const bf16x8 sa = *(const LAS bf16x8*)(ST + vrow * 272 + kk * 64 + q * 16); oT[vt] = MFMA16(sa, bq[kk], oT[vt]); } } }
            float ss = 0.f;
#pragma unroll
            for (int pp = 0; pp < 4; ++pp) { const u32x4 ol = olv[pp];
                oT[2 * pp][0] += bf_lo(ol.x); oT[2 * pp][1] += bf_hi(ol.x); oT[2 * pp][2] += bf_lo(ol.y); oT[2 * pp][3] += bf_hi(ol.y);
                oT[2 * pp + 1][0] += bf_lo(ol.z); oT[2 * pp + 1][1] += bf_hi(ol.z); oT[2 * pp + 1][2] += bf_lo(ol.w); oT[2 * pp + 1][3] += bf_hi(ol.w); }
#pragma unroll
            for (int vt = 0; vt < 8; ++vt) ss += (oT[vt][0] * oT[vt][0] + oT[vt][1] * oT[vt][1]) + (oT[vt][2] * oT[vt][2] + oT[vt][3] * oT[vt][3]);
            ss += __shfl_xor(ss, 16); ss += __shfl_xor(ss, 32);
            const float rstd = rsqrtf(ss * (1.f / 128.f) + EPS);
#pragma unroll
            for (int pp = 0; pp < 4; ++pp) { const u32x4 gv = gvv[pp]; const f32x4 g0 = *(const f32x4*)(gnorm + h * 128 + 32 * pp + 8 * q), g1 = *(const f32x4*)(gnorm + h * 128 + 32 * pp + 8 * q + 4);
                u32x4 w;
                w.x = pk2(oT[2 * pp][0] * rstd * g0[0] * bf_lo(gv.x), oT[2 * pp][1] * rstd * g0[1] * bf_hi(gv.x)); w.y = pk2(oT[2 * pp][2] * rstd * g0[2] * bf_lo(gv.y), oT[2 * pp][3] * rstd * g0[3] * bf_hi(gv.y));
                w.z = pk2(oT[2 * pp + 1][0] * rstd * g1[0] * bf_lo(gv.z), oT[2 * pp + 1][1] * rstd * g1[1] * bf_hi(gv.z)); w.w = pk2(oT[2 * pp + 1][2] * rstd * g1[2] * bf_lo(gv.w), oT[2 * pp + 1][3] * rstd * g1[3] * bf_hi(gv.w));
                *(u32x4*)(rowp + 2048 + 32 * pp + 8 * q) = w; } }
        __syncthreads();
    }
}

#ifndef PHASE_TABLE
#define PHASE_TABLE
constexpr int NPHASE = 24;
__constant__ unsigned char PH_KIND[NPHASE] = {0, 1, 2, 6, 7, 8, 1, 3, 4, 6, 7, 8, 1, 5, 2, 6, 7, 8, 1, 2, 6, 7, 8, 9};
__constant__ unsigned char PH_L[NPHASE]    = {0, 0, 0, 0, 0, 0, 1, 1, 1, 1, 1, 1, 2, 2, 2, 2, 2, 2, 3, 3, 3, 3, 3, 3};
#endif
__global__ void __launch_bounds__(NTHR, 2) fwd_megakernel(Params p_unused) {
    extern __shared__ __attribute__((aligned(16))) unsigned char lds_raw[];
    LAS unsigned char* lds = (LAS unsigned char*)lds_raw;
    cg::grid_group grid = cg::this_grid();
    { PP p0 = (PP)__builtin_amdgcn_kernarg_segment_ptr(); if (threadIdx.x < 16) ((LAS unsigned*)(lds + LDS_CTL))[threadIdx.x] = 0u; __syncthreads();
      (void)xcd_barrier_post((unsigned*)(p0->ws + WS_BAR), (volatile LAS unsigned*)(lds + LDS_CTL)); }
    for (int ph = 0; ph < NPHASE; ++ph) {
        PP p = (PP)__builtin_amdgcn_kernarg_segment_ptr(); asm volatile("" : "+s"(p));
        const int kind = PH_KIND[ph], L = PH_L[ph], mix = L % 3, jx = L / 3;
        int tid = threadIdx.x, bid = blockIdx.x, nblk = gridDim.x; asm volatile("" : "+v"(tid), "+s"(bid), "+s"(nblk));
        const int lane = tid & 63, wave = __builtin_amdgcn_readfirstlane(tid >> 6);
        const int gw = bid * NWV + wave, ngw = nblk * NWV;
        LAS float* scr = (LAS float*)(lds + wave * CONV_SCR_BYTES);
        bf16_t* BIG = (bf16_t*)(p->ws + WS_BIG); bf16_t* XB = (bf16_t*)(p->ws + WS_XB); bf16_t* WMIX = (bf16_t*)(p->ws + WS_WMIX); bf16_t* WMLP = (bf16_t*)(p->ws + WS_WMLP);
        float* SSQ = (float*)(p->ws + WS_SSQ);
        if (kind == 0) {
            conv_mix(p, 0, scr, gw, ngw, lane);
            { f32x4 nv[4] = {{0.f, 0.f, 0.f, 0.f}, {0.f, 0.f, 0.f, 0.f}, {0.f, 0.f, 0.f, 0.f}, {0.f, 0.f, 0.f, 0.f}};
              if (gw < T) { const f32x4* xr = (const f32x4*)(p->in[0] + (size_t)gw * D) + lane;
#pragma unroll
                  for (int j = 0; j < 4; ++j) nv[j] = __builtin_nontemporal_load(xr + 64 * j); }
              for (int m = gw; m < T; m += ngw) { f32x4 v[4]; float s = 0.f;
#pragma unroll
                  for (int j = 0; j < 4; ++j) v[j] = nv[j];
                  if (m + ngw < T) { const f32x4* xr = (const f32x4*)(p->in[0] + (size_t)(m + ngw) * D) + lane;
#pragma unroll
                      for (int j = 0; j < 4; ++j) nv[j] = __builtin_nontemporal_load(xr + 64 * j); }
#pragma unroll
                  for (int j = 0; j < 4; ++j) s += (v[j][0] * v[j][0] + v[j][1] * v[j][1]) + (v[j][2] * v[j][2] + v[j][3] * v[j][3]);
                  s = wave_sum(s); if (lane < 16) SSQ[(size_t)m * 16 + lane] = (lane == 0) ? s : 0.f;
                  u32x2* o = (u32x2*)(XB + (size_t)m * D) + lane;
#pragma unroll
                  for (int j = 0; j < 4; ++j) { u32x2 w; w.x = pk2(v[j][0], v[j][1]); w.y = pk2(v[j][2], v[j][3]); o[64 * j] = w; } } }
        } else if (kind == 1 || kind == 7) {
            if (kind == 7 && L < 3) { conv_mix(p, L + 1, scr, gw, ngw, lane); __syncthreads(); }
            if (kind == 1 && mix == 0) {
                const int lo = (384 - nblk > 0 && 384 - nblk < nblk) ? 384 - nblk : 0;
                if (bid >= lo) conv_mlp(p, L, scr, (bid - lo) * NWV + wave, (nblk - lo) * NWV, lane);
                __syncthreads(); }
            if (kind == 1 && mix == 2) fox_flog(p, SSQ + (size_t)(2 * L) * T * 16, p->in[15] + jx * 3088 + 3072, gw, ngw, lane);
            const float* sq = SSQ + (size_t)((kind == 7) ? 2 * L + 1 : 2 * L) * T * 16;
            const int ncols = (kind == 7 || mix == 1) ? 4096 : (mix == 0 ? 1536 : 3072);
            int pmc = -1;
            { const int nN = ncols / 256, nwg = 64 * nN; if (bid < nwg) { const int qq = nwg / 8, rr = nwg % 8, xcd = bid % 8, off = bid / 8;
                const int wgid = (xcd < rr ? xcd * (qq + 1) : rr * (qq + 1) + (xcd - rr) * qq) + off; const int nig = 8 * nN, fm = (wgid / nig) * 8, gsz = (64 - fm) < 8 ? (64 - fm) : 8;
                pmc = fm + ((wgid % nig) % gsz); } }
            LAS float* rsl = (LAS float*)(lds + 131072);
            if (tid < 256 && pmc >= 0) rsl[tid] = row_rstd(sq, pmc * 256 + tid);
            __syncthreads();
            if (kind == 7 || mix == 1) { pg8::EpiAct E;
                if (kind == 7) E = pg8::EpiAct{BIG, nullptr, sq, 0x55555555u  , 0, 1.f, rsl, pmc};
                else E = pg8::EpiAct{BIG, nullptr, sq, 0xAA0000AAu  , 0, 1.f, rsl, pmc};
                run_gemm<pg8::EpiAct, 4096, 1024, 1024>(lds, XB, (kind == 7) ? WMLP : WMIX, E, tid, bid, nblk); }
            else if (mix == 0) { pg8::EpiAct E{BIG, p->in[7] + jx * 1536, sq, 0u, 4, 0.125f * LOG2E, rsl, pmc}; run_gemm<pg8::EpiAct, 1536, 1024, 1024>(lds, XB, WMIX, E, tid, bid, nblk); }
            else { pg8::EpiAct E{BIG, p->in[15] + jx * 3088, sq, 0u, 4, 0.125f * LOG2E, rsl, pmc}; run_gemm<pg8::EpiAct, 3072, 1024, 1024>(lds, XB, WMIX, E, tid, bid, nblk); }
        } else if (kind == 6 || kind == 8) {
            pg8::EpiResid E; const bf16_t* A; const bf16_t* Bt;
            if (kind == 8) { E = pg8::EpiResid{XB, SSQ + (size_t)(2 * L + 2) * T * 16}; run_gemm<pg8::EpiResid, 1024, 4096, 4096>(lds, BIG, WMLP + 4096 * 1024, E, tid, bid, nblk); }
            else { E = pg8::EpiResid{XB, SSQ + (size_t)(2 * L + 1) * T * 16};
                if (mix == 0) { A = BIG + 2048; Bt = WMIX + 1536 * 1024; } else if (mix == 1) { A = BIG + 2048; Bt = WMIX + 4096 * 1024; } else { A = BIG + 3072; Bt = WMIX + 3072 * 1024; }
                run_gemm<pg8::EpiResid, 1024, 1024, 4096>(lds, A, Bt, E, tid, bid, nblk); }
        } else if (kind == 2) {
            if (mix != 0) { conv_mlp(p, L, scr, gw, ngw, lane); __syncthreads(); }
            if (mix == 0) swa_phase(lds, BIG, p->in[8] + jx * 16, tid, bid, nblk);
            else { AttnCfg c{BIG, 4096, 1024, 2048, 3072, 1, nullptr, (const float*)(p->ws + WS_C2), (const float*)(p->ws + WS_PK), (const float*)(p->ws + WS_SEG)}; attn_phase(lds, c, tid, bid, nblk); }
        } else if (kind == 3) {
            conv_mlp(p, L, scr, gw, ngw, lane); __syncthreads();
            hgrn_x1(lds, p, L, tid, bid, nblk);
        } else if (kind == 4) {
            hgrn_x3(lds, p, p->in[12] + jx * 1024, tid, bid, nblk);
        } else if (kind == 5) {
            fox_scan(lds, p, tid, bid, nblk);
        } else if (kind == 9) {
            const float* ssq = SSQ + (size_t)8 * T * 16; const float* gf = p->in[3];
            { u32x2 nb[4] = {{0u, 0u}, {0u, 0u}, {0u, 0u}, {0u, 0u}}; float nrs = 0.f;
              if (gw < T) { const u32x2* xs = (const u32x2*)(XB + (size_t)gw * D) + lane; nrs = row_rstd(ssq, gw);
#pragma unroll
                  for (int j = 0; j < 4; ++j) nb[j] = xs[64 * j]; }
              for (int m = gw; m < T; m += ngw) { f32x4* xr = (f32x4*)(p->out + (size_t)m * D) + lane; u32x2 b[4]; const float rs = nrs;
#pragma unroll
                  for (int j = 0; j < 4; ++j) b[j] = nb[j];
                  if (m + ngw < T) { const u32x2* xs = (const u32x2*)(XB + (size_t)(m + ngw) * D) + lane; nrs = row_rstd(ssq, m + ngw);
#pragma unroll
                      for (int j = 0; j < 4; ++j) nb[j] = xs[64 * j]; }
#pragma unroll
                  for (int j = 0; j < 4; ++j) { const f32x4 g = *((const f32x4*)gf + lane + 64 * j);
                      f32x4 v = {bf_lo(b[j].x), bf_hi(b[j].x), bf_lo(b[j].y), bf_hi(b[j].y)}; v = v * rs * g; __builtin_nontemporal_store(v, xr + 64 * j); } } }
        }
        if (ph + 1 < NPHASE) {
            if (p->ws == nullptr) {
                grid.sync();
            } else {
                XcdBarrier xb; xb.bar = (unsigned*)(p->ws + WS_BAR); xb.x = xb_xcc_id(); xb.st = (volatile LAS unsigned*)(lds + LDS_CTL);
                xcd_barrier(xb);
            }
        }
    }
}

extern "C" void kernel_launch(void* const* d_in, const int* in_sizes, int n_in, void* d_out, int out_size, void* d_ws, size_t ws_size, hipStream_t stream) {
    static int grid_blocks = 0;
    if (grid_blocks == 0) {
        if (n_in != 17 || out_size != T * D || ws_size < WS_END) { fprintf(stderr, "kernel_launch: unexpected shapes (n_in %d out %d ws %zu)\n", n_in, out_size, ws_size); grid_blocks = -1; return; }
        int dev = 0, cus = 0, per_cu = 0;
        (void)hipGetDevice(&dev); (void)hipDeviceGetAttribute(&cus, hipDeviceAttributeMultiprocessorCount, dev);
        (void)hipFuncSetAttribute((const void*)fwd_megakernel, hipFuncAttributeMaxDynamicSharedMemorySize, LDS_BYTES);
        (void)hipOccupancyMaxActiveBlocksPerMultiprocessor(&per_cu, (const void*)fwd_megakernel, NTHR, LDS_BYTES);
        if (per_cu < 1) per_cu = 1;
        grid_blocks = cus * 1;
        (void)hipGetLastError();
    }
    if (grid_blocks < 0) return;
    (void)hipMemsetAsync((char*)d_ws + WS_BAR, 0, 16384, stream);
    Params p{};
    for (int i = 0; i < 17; ++i) p.in[i] = (const float*)d_in[i];
    p.out = (float*)d_out; p.ws = (unsigned char*)d_ws;
    void* args[] = {&p};
    hipError_t e = hipLaunchCooperativeKernel((const void*)fwd_megakernel, dim3(grid_blocks), dim3(NTHR), args, LDS_BYTES, stream);
    if (e != hipSuccess) fprintf(stderr, "cooperative launch failed: %s (grid %d)\n", hipGetErrorString(e), grid_blocks);
}
```
